# Optimizing an MI355X kernel written in HIP

```python
import math
import jax, jax.numpy as jnp
from jax import lax
import numpy as np

D_MODEL = 1024
BATCH = 4
SEQ = 4096
DEPTH = 4

N_MIXERS = 2
N_HEADS = 16
HEAD_DIM = D_MODEL // N_HEADS
FOX_Q_BLOCK = 128
MOBA_BLOCK = 256
MOBA_TOP_K = 3
MOBA_Q_CHUNK = 32
REL_BUCKETS = 32
REL_MAX_DIST = 128
D_FF = ((8 * D_MODEL // 3 + 255) // 256) * 256
PLE_DIM = 256
RMS_EPS = 1e-6
N_FOX = (DEPTH + 1) // 2
N_MOBA = DEPTH // 2

kernel_name = "hybrid_fox_moba_t5bias_swiglu_ple"


def _rmsnorm(x, g):
    x32 = x.astype(jnp.float32)
    y = x32 * lax.rsqrt(jnp.mean(x32 * x32, axis=-1, keepdims=True) + RMS_EPS)
    return (y * g.astype(jnp.float32)).astype(x.dtype)


def _heads(t):
    b, s, _ = t.shape
    return t.reshape(b, s, N_HEADS, HEAD_DIM).transpose(0, 2, 1, 3)


def _merge_heads(o):
    b, h, s, d = o.shape
    return o.transpose(0, 2, 1, 3).reshape(b, s, h * d)


def _t5_bucket(rel):
    n = jnp.maximum(rel, 0)
    max_exact = REL_BUCKETS // 2
    nf = jnp.maximum(n, 1).astype(jnp.float32)
    large = max_exact + (jnp.log(nf / max_exact) / math.log(REL_MAX_DIST / max_exact)
                         * (REL_BUCKETS - max_exact)).astype(jnp.int32)
    large = jnp.minimum(large, REL_BUCKETS - 1)
    return jnp.where(n < max_exact, n, large)


def _fox_attention(q, k, v, log_f):
    b, h, s, d = q.shape
    nb = s // FOX_Q_BLOCK
    scale = HEAD_DIM ** -0.5
    c = jnp.cumsum(log_f, axis=-1)
    qb = q.reshape(b, h, nb, FOX_Q_BLOCK, d).transpose(2, 0, 1, 3, 4)
    cqb = c.reshape(b, h, nb, FOX_Q_BLOCK).transpose(2, 0, 1, 3)
    key_pos = jnp.arange(s)

    def block(args):
        qblk, cq, j = args
        t = j * FOX_Q_BLOCK + jnp.arange(FOX_Q_BLOCK)
        logits = jnp.einsum('bhqd,bhkd->bhqk', qblk, k).astype(jnp.float32) * scale
        logits = logits + cq[..., None] - c[:, :, None, :]
        logits = jnp.where(key_pos[None, :] <= t[:, None], logits, -jnp.inf)
        probs = jax.nn.softmax(logits, axis=-1).astype(v.dtype)
        return jnp.einsum('bhqk,bhkd->bhqd', probs, v)

    out = lax.map(block, (qb, cqb, jnp.arange(nb)))
    return out.transpose(1, 2, 0, 3, 4).reshape(b, h, s, d)


def _moba_attention(q, k, v, rel_table):
    b, h, s, d = q.shape
    scale = HEAD_DIM ** -0.5
    nblk = -(-s // MOBA_BLOCK)
    pad = nblk * MOBA_BLOCK - s
    kp = jnp.pad(k, ((0, 0), (0, 0), (0, pad), (0, 0)))
    vp = jnp.pad(v, ((0, 0), (0, 0), (0, pad), (0, 0)))
    kb = kp.reshape(b, h, nblk, MOBA_BLOCK, d)
    vb = vp.reshape(b, h, nblk, MOBA_BLOCK, d)
    kmean = jnp.mean(kb.astype(jnp.float32), axis=3).astype(q.dtype)
    n_sel = min(MOBA_TOP_K, nblk)
    n_chunks = s // MOBA_Q_CHUNK
    qc = q.reshape(b, h, n_chunks, MOBA_Q_CHUNK, d).transpose(2, 0, 1, 3, 4)
    table_ht = rel_table.T.astype(jnp.float32)
    bi = jnp.arange(b)[:, None, None, None]
    hi = jnp.arange(h)[None, :, None, None]
    hi5 = jnp.arange(h)[None, :, None, None, None]
    blk_ids = jnp.arange(nblk)
    in_blk = jnp.arange(MOBA_BLOCK)

    def chunk(args):
        qblk, ci = args
        t = ci * MOBA_Q_CHUNK + jnp.arange(MOBA_Q_CHUNK)
        own = (ci * MOBA_Q_CHUNK) // MOBA_BLOCK
        gate = jnp.einsum('bhqd,bhnd->bhqn', qblk, kmean).astype(jnp.float32)
        gate = jnp.where(blk_ids < own, gate, -jnp.inf)
        _, idx = lax.top_k(gate, n_sel)
        sel_valid = idx < own
        kg = kb[bi, hi, idx]
        vg = vb[bi, hi, idx]
        s_g = jnp.einsum('bhqd,bhqnkd->bhqnk', qblk, kg).astype(jnp.float32) * scale
        pos_g = idx[..., None] * MOBA_BLOCK + in_blk
        rel_g = t[None, None, :, None, None] - pos_g
        s_g = s_g + table_ht[hi5, _t5_bucket(rel_g)]
        s_g = jnp.where(sel_valid[..., None], s_g, -jnp.inf)
        ko = lax.dynamic_slice_in_dim(kp, own * MOBA_BLOCK, MOBA_BLOCK, axis=2)
        vo = lax.dynamic_slice_in_dim(vp, own * MOBA_BLOCK, MOBA_BLOCK, axis=2)
        s_o = jnp.einsum('bhqd,bhkd->bhqk', qblk, ko).astype(jnp.float32) * scale
        rel_o = t[:, None] - (own * MOBA_BLOCK + in_blk)[None, :]
        s_o = s_o + table_ht[:, _t5_bucket(rel_o)][None]
        s_o = jnp.where(rel_o >= 0, s_o, -jnp.inf)
        logits = jnp.concatenate(
            [s_g.reshape(b, h, MOBA_Q_CHUNK, n_sel * MOBA_BLOCK), s_o], axis=-1)
        probs = jax.nn.softmax(logits, axis=-1).astype(v.dtype)
        p_g = probs[..., :n_sel * MOBA_BLOCK].reshape(b, h, MOBA_Q_CHUNK, n_sel, MOBA_BLOCK)
        p_o = probs[..., n_sel * MOBA_BLOCK:]
        return (jnp.einsum('bhqnk,bhqnkd->bhqd', p_g, vg)
                + jnp.einsum('bhqk,bhkd->bhqd', p_o, vo))

    out = lax.map(chunk, (qc, jnp.arange(n_chunks)))
    return out.transpose(1, 2, 0, 3, 4).reshape(b, h, s, d)


def setup_inputs(seed: int = 0) -> dict:
    key = jax.random.key(seed)
    ks = jax.random.split(key, 20)
    f32 = jnp.float32
    D, H = D_MODEL, N_HEADS
    res_scale = (2.0 * DEPTH) ** -0.5

    def nrm(k, shape, scale):
        return jax.random.normal(k, shape, f32) * scale

    return {
        "x": nrm(ks[0], (BATCH, SEQ, D), 1.0),
        "p": nrm(ks[1], (DEPTH, BATCH, SEQ, PLE_DIM), 1.0),
        "attn_norm_g": 1.0 + nrm(ks[2], (DEPTH, D), 0.02),
        "fox_w_in": nrm(ks[3], (N_FOX, D, 3 * D + H), D ** -0.5),
        "fox_b_f": 2.0 + nrm(ks[4], (N_FOX, H), 0.5),
        "fox_w_o": nrm(ks[5], (N_FOX, D, D), D ** -0.5 * res_scale),
        "moba_w_in": nrm(ks[6], (N_MOBA, D, 3 * D), D ** -0.5),
        "moba_w_o": nrm(ks[7], (N_MOBA, D, D), D ** -0.5 * res_scale),
        "rel_bias_table": nrm(ks[8], (REL_BUCKETS, H), 0.5),
        "ffn_norm_g": 1.0 + nrm(ks[9], (DEPTH, D), 0.02),
        "ffn_w_in": nrm(ks[10], (DEPTH, D, 2 * D_FF), D ** -0.5),
        "ffn_w_out": nrm(ks[11], (DEPTH, D_FF, D), D_FF ** -0.5 * res_scale),
        "ple_norm_g": 1.0 + nrm(ks[12], (DEPTH, D), 0.02),
        "ple_w_gate": nrm(ks[13], (DEPTH, D, D), D ** -0.5),
        "ple_w_up": nrm(ks[14], (DEPTH, PLE_DIM, D), PLE_DIM ** -0.5 * res_scale),
        "final_norm_g": 1.0 + nrm(ks[15], (D,), 0.02),
    }


def reference(x, p, attn_norm_g, fox_w_in, fox_b_f, fox_w_o, moba_w_in, moba_w_o, rel_bias_table,
              ffn_norm_g, ffn_w_in, ffn_w_out, ple_norm_g, ple_w_gate, ple_w_up, final_norm_g):
    D = D_MODEL
    h = x
    for i in range(DEPTH):
        u = _rmsnorm(h, attn_norm_g[i])
        j = i // N_MIXERS
        if i % N_MIXERS == 0:
            proj = u @ fox_w_in[j]
            q, k, v = _heads(proj[..., :D]), _heads(proj[..., D:2 * D]), _heads(proj[..., 2 * D:3 * D])
            f_logit = proj[..., 3 * D:].astype(jnp.float32) + fox_b_f[j].astype(jnp.float32)
            log_f = jax.nn.log_sigmoid(f_logit).transpose(0, 2, 1)
            o = _fox_attention(q, k, v, log_f)
            h = h + _merge_heads(o) @ fox_w_o[j]
        else:
            proj = u @ moba_w_in[j]
            q, k, v = _heads(proj[..., :D]), _heads(proj[..., D:2 * D]), _heads(proj[..., 2 * D:])
            o = _moba_attention(q, k, v, rel_bias_table)
            h = h + _merge_heads(o) @ moba_w_o[j]
        u = _rmsnorm(h, ffn_norm_g[i])
        gu = u @ ffn_w_in[i]
        h = h + (jax.nn.silu(gu[..., :D_FF]) * gu[..., D_FF:]) @ ffn_w_out[i]
        gate = jax.nn.sigmoid(_rmsnorm(h, ple_norm_g[i]) @ ple_w_gate[i])
        h = h + gate * (p[i] @ ple_w_up[i])
    return _rmsnorm(h, final_norm_g)
```

```cpp
#include <hip/hip_runtime.h>
#include <hip/hip_cooperative_groups.h>
#include <cstdio>
#include <cstdint>
#include <cmath>
namespace cg = cooperative_groups;
namespace pg8 {
#define PG8_LAS __attribute__((address_space(3)))
typedef unsigned short bf16_t;
typedef short bf16x8 __attribute__((ext_vector_type(8)));
typedef float f32x4 __attribute__((ext_vector_type(4)));
typedef unsigned u32x4 __attribute__((ext_vector_type(4)));
constexpr int BM = 256, BK = 64, HALF = 128, HTB = HALF * BK * 2  , STAGE_BYTES = 8 * HTB, NXCD = 8, WGM = 8;

__host__ __device__ __forceinline__ int lds_byte(int r, int c) { const int st = (r >> 4) * 2 + (c >> 5), rr = r & 15, cc = c & 31, ob = rr * 64 + cc * 2; return st * 1024 + (ob ^ (((ob >> 9) & 1) << 5)); }
__host__ __device__ __forceinline__ void stage_rc(int b, int& R, int& C) { const int st = b / 1024, sb = b % 1024, swz = sb ^ (((sb >> 9) & 1) << 5); R = (st >> 1) * 16 + swz / 64; C = (st & 1) * 32 + (swz % 64) / 2; }
__host__ __device__ __forceinline__ int perm32(int rho) { const int n = rho >> 4, i = rho & 15; return 8 * (i >> 2) + 4 * n + (i & 3); }

__device__ __forceinline__ int lane_id() { unsigned m = ~0u; asm volatile("" : "+s"(m)); return (int)__builtin_amdgcn_mbcnt_hi(m, __builtin_amdgcn_mbcnt_lo(m, 0u)); }
template <int MASK> __device__ __forceinline__ float xor_lane(float v) {
    if constexpr (MASK == 32) { auto rr = __builtin_amdgcn_permlane32_swap(__float_as_uint(v), __float_as_uint(v), false, false);
        const unsigned own = __float_as_uint(v); return __uint_as_float(rr[0] ^ rr[1] ^ own); }
    else return __int_as_float(__builtin_amdgcn_ds_swizzle(__float_as_int(v), (MASK << 10) | 0x1f));
}
typedef _Float16 f16x8 __attribute__((ext_vector_type(8)));
template <bool F16> __device__ __forceinline__ f32x4 mma16(bf16x8 a, bf16x8 b, f32x4 c) {
    if constexpr (F16) return __builtin_amdgcn_mfma_f32_16x16x32_f16(__builtin_bit_cast(f16x8, a), __builtin_bit_cast(f16x8, b), c, 0, 0, 0);
    else return __builtin_amdgcn_mfma_f32_16x16x32_bf16(a, b, c, 0, 0, 0);
}
struct Unit { int pm, pn; };
struct Gemm { const bf16_t* A; const bf16_t* Bt; int M, N, K; };

struct StaticOrder {
    int nM, nN, nwg, G, c;
    __host__ __device__ void init(int M, int N, int G_, int c_) { nM = M / BM; nN = N / BM; nwg = nM * nN; G = G_; c = c_; }
    __host__ __device__ bool next(int i, Unit& u) const {
        const long L = (long)i * G + c; if (L >= nwg) return false;
        int wgid = (int)L; { const int q = nwg / NXCD, r = nwg % NXCD, xcd = wgid % NXCD, off = wgid / NXCD; wgid = (xcd < r ? xcd * (q + 1) : r * (q + 1) + (xcd - r) * q) + off; }
        const int nig = WGM * nN, gid = wgid / nig, fm = gid * WGM, gsz = (nM - fm) < WGM ? (nM - fm) : WGM;
        u.pm = fm + ((wgid % nig) % gsz); u.pn = (wgid % nig) / gsz; return true;
    }
    __device__ __forceinline__ void a_ready(const Unit&) const {}
    __device__ __forceinline__ void done(const Unit&) const {}
};

typedef float f32x2cv __attribute__((ext_vector_type(2))); typedef __bf16 bf16x2cv __attribute__((ext_vector_type(2)));
__device__ __forceinline__ unsigned cvt_pk_bf16(float lo, float hi) { const f32x2cv v = {lo, hi}; const bf16x2cv b = __builtin_convertvector(v, bf16x2cv); return __builtin_bit_cast(unsigned, b); }
typedef float f32x2 __attribute__((ext_vector_type(2)));
constexpr float RMS_EPS = 1e-6f;
constexpr float LOG2E = 1.4426950408889634f;
typedef unsigned u32x2 __attribute__((ext_vector_type(2)));
__device__ __forceinline__ float rstd_of(float ssq) { return __builtin_amdgcn_rsqf(ssq * (1.0f / 1024.0f) + RMS_EPS); }
__device__ __forceinline__ float rstd_row(const float* ssq16, int row) { const f32x4* p = (const f32x4*)(ssq16 + (size_t)row * 16); const f32x4 a = p[0], b = p[1], c = p[2], d = p[3];
    return rstd_of((((a[0] + a[1]) + (a[2] + a[3])) + ((b[0] + b[1]) + (b[2] + b[3]))) + (((c[0] + c[1]) + (c[2] + c[3])) + ((d[0] + d[1]) + (d[2] + d[3])))); }
__device__ __forceinline__ float rstd_row4(const float* ssq16, int row, int fq) { const f32x4 a = *((const f32x4*)(ssq16 + (size_t)row * 16) + fq);
    float s = (a[0] + a[1]) + (a[2] + a[3]); s += xor_lane<16>(s); s += xor_lane<32>(s); return rstd_of(s); }

typedef _Float16 f16x2_t __attribute__((ext_vector_type(2)));
__device__ __forceinline__ unsigned pk_f16(float lo, float hi) { f16x2_t h; h.x = (_Float16)lo; h.y = (_Float16)hi; return __builtin_bit_cast(unsigned, h); }
__device__ __forceinline__ float f16_lo(unsigned w) { return (float)__builtin_bit_cast(f16x2_t, w).x; }
__device__ __forceinline__ float f16_hi(unsigned w) { return (float)__builtin_bit_cast(f16x2_t, w).y; }
__device__ __forceinline__ float sigmoid_f(float x) { return __builtin_amdgcn_rcpf(1.0f + __builtin_amdgcn_exp2f(-x * LOG2E)); }

#ifndef EPI_WT
#define EPI_WT 0
#endif
__device__ __forceinline__ void st16(void* p, u32x4 v) {
#if EPI_WT
    asm volatile("global_store_dwordx4 %0, %1, off sc1\n\ts_nop 1" :: "v"(p), "v"(v) : "memory");
#else
    *(u32x4*)p = v;
#endif
}
constexpr int RSC_OFF = 131072 + 1024, RSC_STRIDE = 132;
__device__ __forceinline__ void row_factors(float (&rsv)[8], const float* ssq, PG8_LAS unsigned char* ldsb, int pm, int row0, int wid, int fr, int fq) {
    PG8_LAS float* rc = (PG8_LAS float*)(ldsb + RSC_OFF) + wid * RSC_STRIDE;
    const int tag = __builtin_amdgcn_readfirstlane(((PG8_LAS int*)rc)[0]);
    if (tag == pm + 1) {
#pragma unroll
        for (int i = 0; i < 8; ++i) rsv[i] = rc[4 + i * 16 + fr];
    } else {
        f32x4 sq[8];
#pragma unroll
        for (int i = 0; i < 8; ++i) sq[i] = *((const f32x4*)(ssq + (size_t)(row0 + (i >> 2) * HALF + (i & 3) * 16) * 16) + fq);
#pragma unroll
        for (int i = 0; i < 8; ++i) { float s = (sq[i][0] + sq[i][1]) + (sq[i][2] + sq[i][3]); s += xor_lane<16>(s); s += xor_lane<32>(s); rsv[i] = rstd_of(s); if (fq == 0) rc[4 + i * 16 + fr] = rsv[i]; }
        if (fr == 0 && fq == 0) ((PG8_LAS int*)rc)[0] = pm + 1;
    }
}
struct EpiQKV {
    static constexpr bool PERM = true, AFTER_DRAIN = false;
    bf16_t* O; size_t split_stride; const float* ssq; float scale0; unsigned* nq; unsigned* nk; PG8_LAS unsigned char* ldsb;
    __device__ __forceinline__ void operator()(const f32x4 (&acc)[2][2][4][2], const Unit& u, int wr, int wc, int fr, int fq) const {
        asm volatile("" : "+v"(fr), "+v"(fq));
        const int row0 = u.pm * BM + wr * 64 + fr; int colt = u.pn * BM;
        const int t = colt >> 10; bf16_t* base = O + (size_t)t * split_stride; colt &= 1023; const float sc = (t == 0) ? scale0 : 1.f;
        const int col0 = colt + wc * 32 + 8 * fq;
        float rsv[8]; row_factors(rsv, ssq, ldsb, u.pm, row0, wr * 4 + wc, fr, fq);
#pragma unroll
        for (int i = 0; i < 8; ++i) rsv[i] *= sc;
        float mx[2] = {0.f, 0.f};
#pragma unroll
        for (int ai = 0; ai < 2; ++ai)
#pragma unroll
            for (int m = 0; m < 4; ++m) { const int row = row0 + ai * HALF + m * 16; const float rs = rsv[ai * 4 + m];
                bf16_t* rowp = base + (size_t)row * 1024 + col0;
#pragma unroll
                for (int bj = 0; bj < 2; ++bj) { const f32x4 v0 = acc[ai][bj][m][0] * rs, v1 = acc[ai][bj][m][1] * rs;
                    u32x4 w; w.x = cvt_pk_bf16(v0[0], v0[1]); w.y = cvt_pk_bf16(v0[2], v0[3]); w.z = cvt_pk_bf16(v1[0], v1[1]); w.w = cvt_pk_bf16(v1[2], v1[3]);
                    st16(rowp + bj * HALF, w);
                    if (t == 1 || (t == 0 && nq != nullptr)) { float s = (v0[0] * v0[0] + v0[1] * v0[1]) + (v0[2] * v0[2] + v0[3] * v0[3]) + (v1[0] * v1[0] + v1[1] * v1[1]) + (v1[2] * v1[2] + v1[3] * v1[3]);
                        s += xor_lane<16>(s); s += xor_lane<32>(s); mx[bj] = fmaxf(mx[bj], s); } } }
        if (t == 1 || (t == 0 && nq != nullptr)) {
#pragma unroll
            for (int bj = 0; bj < 2; ++bj) { float r = mx[bj]; r = fmaxf(r, xor_lane<1>(r)); r = fmaxf(r, xor_lane<2>(r)); r = fmaxf(r, xor_lane<4>(r)); r = fmaxf(r, xor_lane<8>(r));
                const int head = (colt + bj * HALF + wc * 32) >> 6, half = wc & 1, bb = u.pm >> 4, qb = u.pm & 15;
                if (fr == 0 && fq == 0) { if (t == 0) atomicMax(nq + ((bb * 16 + head) * 16 + qb) * 2 + half, __float_as_uint(r)); else atomicMax(nk + (bb * 16 + head) * 2 + half, __float_as_uint(r)); } }
        }
    }
};
struct EpiSwiGLU {
    static constexpr bool PERM = true, AFTER_DRAIN = false;
    bf16_t* O; const float* ssq; PG8_LAS unsigned char* ldsb;
    __device__ __forceinline__ void operator()(const f32x4 (&acc)[2][2][4][2], const Unit& u, int wr, int wc, int fr, int fq) const {
        asm volatile("" : "+v"(fr), "+v"(fq));
        const int row0 = u.pm * BM + wr * 64 + fr; const int col0 = u.pn * HALF + wc * 32 + 8 * fq;
        float rsv[8]; row_factors(rsv, ssq, ldsb, u.pm, row0, wr * 4 + wc, fr, fq);
#pragma unroll
        for (int ai = 0; ai < 2; ++ai)
#pragma unroll
            for (int m = 0; m < 4; ++m) { const int row = row0 + ai * HALF + m * 16; const float rs = rsv[ai * 4 + m];
                float a[8];
#pragma unroll
                for (int n = 0; n < 2; ++n)
#pragma unroll
                    for (int e = 0; e < 4; ++e) { const float g = acc[ai][0][m][n][e] * rs, uu = acc[ai][1][m][n][e] * rs; a[4 * n + e] = g * sigmoid_f(g) * uu; }
                u32x4 w; w.x = cvt_pk_bf16(a[0], a[1]); w.y = cvt_pk_bf16(a[2], a[3]); w.z = cvt_pk_bf16(a[4], a[5]); w.w = cvt_pk_bf16(a[6], a[7]);
                st16(O + (size_t)row * 2816 + col0, w); }
    }
};
template <int MODE, bool BASEF32, bool OUTF32> struct EpiResid {
    static constexpr bool PERM = true, AFTER_DRAIN = false;
    const void* base; void* outp; float* ssq_out; const float* ssq_in; const bf16_t* up;
    __device__ __forceinline__ void operator()(const f32x4 (&acc)[2][2][4][2], const Unit& u, int wr, int wc, int fr, int fq) const {
        asm volatile("" : "+v"(fr), "+v"(fq));
        const int col0 = u.pn * BM + wc * 32 + 8 * fq;
        constexpr int PF = BASEF32 ? 2 : 4;
#pragma unroll
        for (int g = 0; g < 8 / PF; ++g) {
            u32x4 bw[PF][2], bw2[PF][2], uw[PF][2]; f32x4 sq[PF];
#pragma unroll
            for (int i = 0; i < PF; ++i) { const int gi = g * PF + i, ai = gi >> 2, m = gi & 3; const int row = u.pm * BM + ai * HALF + wr * 64 + m * 16 + fr; const size_t off = (size_t)row * 1024 + col0;
                if (MODE == 1) sq[i] = *((const f32x4*)(ssq_in + (size_t)row * 16) + fq);
#pragma unroll
                for (int bj = 0; bj < 2; ++bj) { const size_t o2 = off + bj * HALF;
                    if (BASEF32) { bw[i][bj] = *(const u32x4*)((const float*)base + o2); bw2[i][bj] = *(const u32x4*)((const float*)base + o2 + 4); }
                    else bw[i][bj] = *(const u32x4*)((const bf16_t*)base + o2);
                    if (MODE == 1) uw[i][bj] = *(const u32x4*)(up + o2); } }
#pragma unroll
            for (int i = 0; i < PF; ++i) { const int gi = g * PF + i, ai = gi >> 2, m = gi & 3; const int row = u.pm * BM + ai * HALF + wr * 64 + m * 16 + fr; const size_t off = (size_t)row * 1024 + col0;
                float rs = 1.f; if (MODE == 1) { float s4 = (sq[i][0] + sq[i][1]) + (sq[i][2] + sq[i][3]); s4 += xor_lane<16>(s4); s4 += xor_lane<32>(s4); rs = rstd_of(s4); }
                float s = 0.f;
#pragma unroll
                for (int bj = 0; bj < 2; ++bj) { const size_t o2 = off + bj * HALF;
                    float bs[8];
                    if (BASEF32) {
#pragma unroll
                        for (int q = 0; q < 4; ++q) { bs[q] = __uint_as_float(bw[i][bj][q]); bs[4 + q] = __uint_as_float(bw2[i][bj][q]); } }
                    else {
#pragma unroll
                        for (int q = 0; q < 4; ++q) { bs[2 * q] = f16_lo(bw[i][bj][q]); bs[2 * q + 1] = f16_hi(bw[i][bj][q]); } }
                    float a[8];
#pragma unroll
                    for (int n = 0; n < 2; ++n)
#pragma unroll
                        for (int e2 = 0; e2 < 4; ++e2) a[4 * n + e2] = acc[ai][bj][m][n][e2];
                    if (MODE == 1) {
#pragma unroll
                        for (int q = 0; q < 4; ++q) { a[2 * q] = sigmoid_f(a[2 * q] * rs) * __uint_as_float(uw[i][bj][q] << 16); a[2 * q + 1] = sigmoid_f(a[2 * q + 1] * rs) * __uint_as_float(uw[i][bj][q] & 0xffff0000u); } }
                    float hn[8];
#pragma unroll
                    for (int q = 0; q < 8; ++q) { hn[q] = bs[q] + a[q]; s += hn[q] * hn[q]; }
                    if (OUTF32) { *(f32x4*)((float*)outp + o2) = (f32x4){hn[0], hn[1], hn[2], hn[3]}; *(f32x4*)((float*)outp + o2 + 4) = (f32x4){hn[4], hn[5], hn[6], hn[7]}; }
                    else { u32x4 w; w.x = pk_f16(hn[0], hn[1]); w.y = pk_f16(hn[2], hn[3]); w.z = pk_f16(hn[4], hn[5]); w.w = pk_f16(hn[6], hn[7]); st16((bf16_t*)outp + o2, w); } }
                s += xor_lane<16>(s); s += xor_lane<32>(s);
                if (fq == 0) ssq_out[(size_t)row * 16 + u.pn * 4 + wc] = s; }
        }
    }
};
struct EpiStoreBf16 {
    static constexpr bool PERM = false, AFTER_DRAIN = false;
    bf16_t* O;
    __device__ __forceinline__ void operator()(const f32x4 (&acc)[2][2][4][2], const Unit& u, int wr, int wc, int fr, int fq) const {
        asm volatile("" : "+v"(fr), "+v"(fq));
        const int col0 = u.pn * BM + wc * 32 + 4 * fq;
#pragma unroll
        for (int ai = 0; ai < 2; ++ai)
#pragma unroll
            for (int m = 0; m < 4; ++m) { const int row = u.pm * BM + ai * HALF + wr * 64 + m * 16 + fr; const size_t off = (size_t)row * 1024 + col0;
#pragma unroll
                for (int bj = 0; bj < 2; ++bj)
#pragma unroll
                    for (int n = 0; n < 2; ++n) { const f32x4 a = acc[ai][bj][m][n]; u32x2 w; w.x = cvt_pk_bf16(a[0], a[1]); w.y = cvt_pk_bf16(a[2], a[3]); *(u32x2*)(hb_ptr(off + bj * HALF + n * 16)) = w; } }
    }
    __device__ __forceinline__ bf16_t* hb_ptr(size_t o) const { return O + o; }
};
template <class Epi, class Sched, bool ALIGN_EPI = false, bool SP2 = false, bool F16 = false>
__device__ __forceinline__ void gemm_phase(PG8_LAS unsigned char* lds, const Gemm g, const Sched& S, const Epi& E, const int wid_in) {
    int lane_ = lane_id(); asm volatile("" : "+v"(lane_));
    const int wid = wid_in, lane = lane_, tid = wid * 64 + lane, wr = wid >> 2, wc = wid & 3, fr = lane & 15, fq = lane >> 4;
    const int K = g.K, nt = K / BK;
    unsigned voffA[2], voffB[2];
#pragma unroll
    for (int i = 0; i < 2; ++i) { int R, C; stage_rc(tid * 16 + i * 8192, R, C); const int Rb = Epi::PERM ? ((R & ~31) + perm32(R & 31)) : R;
        voffA[i] = (unsigned)(R * K + C) * 2u; voffB[i] = (unsigned)(Rb * K + C) * 2u; }
    const size_t kstep = (size_t)(BK * 2);
    const size_t hstep = (size_t)HALF * K * 2;
    const size_t tstep = 2 * hstep;
    const unsigned ldsw = (unsigned)wid * 1024u;
    const int aoff = lds_byte(wr * 64 + fr, fq * 8), boff = lds_byte(wc * 32 + fr, fq * 8);
#define PG8_SA(b, h) (((b) * 2 + (h)) * HTB)
#define PG8_SB(b, h) ((4 + (b) * 2 + (h)) * HTB)
#define PG8_STAGE(bufoff, gbase, voff) do { _Pragma("unroll") for (int _i = 0; _i < 2; ++_i) \
        __builtin_amdgcn_global_load_lds((const unsigned*)((const char*)(gbase) + (voff)[_i]), (PG8_LAS unsigned*)(lds + (bufoff) + ldsw + _i * 8192), 16, 0, 0); } while (0)
#define PG8_LDA(dst, b, h) do { _Pragma("unroll") for (int m = 0; m < 4; ++m) _Pragma("unroll") for (int k = 0; k < 2; ++k) dst[m][k] = *(const PG8_LAS bf16x8*)(lds + PG8_SA(b, h) + aoff + m * 2048 + k * 1024); } while (0)
#define PG8_LDB(dst, b, h) do { _Pragma("unroll") for (int n = 0; n < 2; ++n) _Pragma("unroll") for (int k = 0; k < 2; ++k) dst[n][k] = *(const PG8_LAS bf16x8*)(lds + PG8_SB(b, h) + boff + n * 2048 + k * 1024); } while (0)
#define PG8_MMA(ai, bj, At, Bt) do { __builtin_amdgcn_s_setprio(1); _Pragma("unroll") for (int m = 0; m < 4; ++m) _Pragma("unroll") for (int n = 0; n < 2; ++n) _Pragma("unroll") for (int k = 0; k < 2; ++k) \
        acc[ai][bj][m][n] = mma16<F16>(Bt[n][k], At[m][k], acc[ai][bj][m][n]); __builtin_amdgcn_s_setprio(0); } while (0)
#define PG8_WAIT_V(n) asm volatile("s_waitcnt vmcnt(" #n ")" ::: "memory")
#define PG8_WAIT_L(n) asm volatile("s_waitcnt lgkmcnt(" #n ")" ::: "memory")
#define PG8_BAR __builtin_amdgcn_s_barrier()
#define PG8_SCHED __builtin_amdgcn_sched_barrier(0)
    Unit cur, nxt; int ui = 0;
    if (!S.next(0, cur)) return;
    f32x4 acc[2][2][4][2];
#pragma unroll
    for (int a = 0; a < 2; ++a)
#pragma unroll
        for (int b = 0; b < 2; ++b)
#pragma unroll
            for (int m = 0; m < 4; ++m)
#pragma unroll
                for (int n = 0; n < 2; ++n) acc[a][b][m][n] = (f32x4){0.f, 0.f, 0.f, 0.f};
    bf16x8 At[4][2], B0[2][2], B1[2][2];
    const char* cA = (const char*)g.A + (size_t)cur.pm * tstep; const char* cB = (const char*)g.Bt + (size_t)cur.pn * tstep;
    S.a_ready(cur);
    if constexpr (SP2) {
        PG8_STAGE(PG8_SB(0, 0), cB, voffB); PG8_STAGE(PG8_SB(0, 1), cB + hstep, voffB); PG8_STAGE(PG8_SA(0, 0), cA, voffA); PG8_STAGE(PG8_SA(0, 1), cA + hstep, voffA);
        if (wr == 1) PG8_BAR;
        PG8_WAIT_V(2); PG8_BAR;
        PG8_STAGE(PG8_SB(1, 0), cB + kstep, voffB); PG8_STAGE(PG8_SA(1, 0), cA + kstep, voffA); PG8_STAGE(PG8_SB(1, 1), cB + hstep + kstep, voffB);
        PG8_WAIT_V(6); PG8_BAR;
    } else {
        PG8_STAGE(PG8_SB(0, 0), cB, voffB); PG8_STAGE(PG8_SA(0, 0), cA, voffA); PG8_STAGE(PG8_SB(0, 1), cB + hstep, voffB); PG8_STAGE(PG8_SA(0, 1), cA + hstep, voffA);
        if (wr == 1) PG8_BAR;
        PG8_WAIT_V(4); PG8_BAR;
        PG8_STAGE(PG8_SB(1, 0), cB + kstep, voffB); PG8_STAGE(PG8_SA(1, 0), cA + kstep, voffA); PG8_STAGE(PG8_SB(1, 1), cB + hstep + kstep, voffB);
        PG8_WAIT_V(6); PG8_BAR;
    }
    for (;;) {
        const bool has_next = S.next(ui + 1, nxt);
        const char* nA = has_next ? (const char*)g.A + (size_t)nxt.pm * tstep : cA; const char* nB = has_next ? (const char*)g.Bt + (size_t)nxt.pn * tstep : cB;
        for (int t = 0; t < nt; t += 2) {
            const bool last = (t == nt - 2);
            const char* a1 = cA + (size_t)(t + 1) * kstep;
            const char* a2 = last ? nA : cA + (size_t)(t + 2) * kstep; const char* b2 = last ? nB : cB + (size_t)(t + 2) * kstep;
            const char* a3 = a2 + kstep; const char* b3 = b2 + kstep;
            if (last && has_next) S.a_ready(nxt);
            if constexpr (SP2) {
            PG8_LDB(B0, 0, 0); PG8_LDB(B1, 0, 1); PG8_SCHED; PG8_LDA(At, 0, 0); PG8_STAGE(PG8_SA(1, 1), a1 + hstep, voffA);
            PG8_WAIT_V(8); PG8_WAIT_L(0); PG8_BAR; PG8_MMA(0, 0, At, B0); PG8_MMA(0, 1, At, B1); PG8_BAR; PG8_SCHED;
            PG8_LDA(At, 0, 1); PG8_STAGE(PG8_SB(0, 0), b2, voffB); PG8_STAGE(PG8_SB(0, 1), b2 + hstep, voffB); PG8_STAGE(PG8_SA(0, 0), a2, voffA);
            PG8_WAIT_V(8); PG8_WAIT_L(0); PG8_BAR; PG8_MMA(1, 0, At, B0); PG8_MMA(1, 1, At, B1); PG8_BAR; PG8_SCHED;
            PG8_LDB(B0, 1, 0); PG8_LDB(B1, 1, 1); PG8_SCHED; PG8_LDA(At, 1, 0); PG8_STAGE(PG8_SA(0, 1), a2 + hstep, voffA);
            PG8_WAIT_V(8); PG8_WAIT_L(0); PG8_BAR; PG8_MMA(0, 0, At, B0); PG8_MMA(0, 1, At, B1); PG8_BAR; PG8_SCHED;
            PG8_LDA(At, 1, 1); PG8_STAGE(PG8_SB(1, 0), b3, voffB); PG8_STAGE(PG8_SB(1, 1), b3 + hstep, voffB); PG8_STAGE(PG8_SA(1, 0), a3, voffA);
            PG8_WAIT_V(8); PG8_WAIT_L(0); PG8_BAR; PG8_MMA(1, 0, At, B0); PG8_MMA(1, 1, At, B1); PG8_BAR; PG8_SCHED;
            } else {
            PG8_LDB(B0, 0, 0); PG8_SCHED; PG8_LDA(At, 0, 0); PG8_STAGE(PG8_SA(1, 1), a1 + hstep, voffA);
            PG8_WAIT_L(8); PG8_BAR; PG8_WAIT_L(0); PG8_MMA(0, 0, At, B0); PG8_BAR; PG8_SCHED;
            PG8_LDB(B1, 0, 1); PG8_STAGE(PG8_SB(0, 0), b2, voffB);
            PG8_BAR; PG8_WAIT_L(0); PG8_MMA(0, 1, At, B1); PG8_BAR;
            PG8_LDA(At, 0, 1); PG8_STAGE(PG8_SA(0, 0), a2, voffA);
            PG8_BAR; PG8_WAIT_L(0); PG8_MMA(1, 0, At, B0); PG8_BAR; PG8_SCHED;
            PG8_STAGE(PG8_SB(0, 1), b2 + hstep, voffB);
            PG8_WAIT_V(6); PG8_BAR; PG8_MMA(1, 1, At, B1); PG8_BAR;
            PG8_LDB(B0, 1, 0); PG8_SCHED; PG8_LDA(At, 1, 0); PG8_STAGE(PG8_SA(0, 1), a2 + hstep, voffA);
            PG8_WAIT_L(8); PG8_BAR; PG8_WAIT_L(0); PG8_MMA(0, 0, At, B0); PG8_BAR; PG8_SCHED;
            PG8_LDB(B1, 1, 1); PG8_STAGE(PG8_SB(1, 0), b3, voffB);
            PG8_BAR; PG8_WAIT_L(0); PG8_MMA(0, 1, At, B1); PG8_BAR;
            PG8_LDA(At, 1, 1); PG8_STAGE(PG8_SA(1, 0), a3, voffA);
            PG8_BAR; PG8_WAIT_L(0); PG8_MMA(1, 0, At, B0); PG8_BAR; PG8_SCHED;
            PG8_STAGE(PG8_SB(1, 1), b3 + hstep, voffB);
            PG8_WAIT_V(6); PG8_BAR; PG8_MMA(1, 1, At, B1); PG8_BAR;
            }
        }
        if constexpr (ALIGN_EPI) { if (wr == 0) PG8_BAR; }
        if constexpr (!Epi::AFTER_DRAIN) { E(acc, cur, wr, wc, fr, fq); S.done(cur); }
        if (!has_next) break;
#pragma unroll
        for (int a = 0; a < 2; ++a)
#pragma unroll
            for (int b = 0; b < 2; ++b)
#pragma unroll
                for (int m = 0; m < 4; ++m)
#pragma unroll
                    for (int n = 0; n < 2; ++n) acc[a][b][m][n] = (f32x4){0.f, 0.f, 0.f, 0.f};
        cur = nxt; cA = nA; cB = nB; ++ui;
        if constexpr (ALIGN_EPI) { if (wr == 1) PG8_BAR; }
    }
    PG8_WAIT_V(0);
    if constexpr (!ALIGN_EPI) { if (wr == 0) PG8_BAR; }
    PG8_BAR;
    if constexpr (Epi::AFTER_DRAIN) { E.fused(acc, cur, wr, wc, fr, fq, lds, wid, lane); S.done(cur); }
#undef PG8_SA
#undef PG8_SB
#undef PG8_STAGE
#undef PG8_LDA
#undef PG8_LDB
#undef PG8_MMA
#undef PG8_WAIT_V
#undef PG8_WAIT_L
#undef PG8_BAR
#undef PG8_SCHED
}
}
#ifndef ATT_LOCKSTEP
#define ATT_LOCKSTEP 0
#endif
namespace att {
#define ATT_LAS __attribute__((address_space(3)))
typedef unsigned short bf16_t;
using bf16x8 = __attribute__((ext_vector_type(8))) short;
using s16x4 = __attribute__((ext_vector_type(4))) short;
using f32x16 = __attribute__((ext_vector_type(16))) float;
using f32x4 = __attribute__((ext_vector_type(4))) float;
using u32x4 = __attribute__((ext_vector_type(4))) unsigned;
constexpr int SEQ = 4096, DM = 1024, NW = 8, QBLK = 32, QB = 256, KVBLK = 64;
constexpr int SLOTB = 8192, LDS_K = 0, LDS_V = 4 * SLOTB, LDS_WS = 8 * SLOTB, LDS_OST = LDS_WS + NW * 256, LDS_C = LDS_OST + NW * 4096, LDS_KM = LDS_C + 16384, LDS_TB = LDS_KM + 2048,
              LDS_SC = LDS_TB + 3072, LDS_END = LDS_SC + 256;
constexpr float LOG2E = 1.4426950408889634f;
constexpr float C2 = 0.125f * LOG2E;
typedef ATT_LAS const char* lds_cptr;
__device__ __forceinline__ int crow(int r, int hi) { return (r & 3) + 8 * (r >> 2) + 4 * hi; }
__device__ __forceinline__ void glds16(const void* gsrc, unsigned lds_dst) { unsigned keep;
    asm volatile("s_mov_b32 %0, m0\n\ts_mov_b32 m0, %2\n\ts_nop 0\n\tglobal_load_lds_dwordx4 %1, off\n\ts_mov_b32 m0, %0" : "=&s"(keep) : "v"(gsrc), "s"(lds_dst) : "memory"); }
typedef float f32x2_t __attribute__((ext_vector_type(2))); typedef __bf16 bf16x2_t __attribute__((ext_vector_type(2)));
__device__ __forceinline__ unsigned cvtpk_s(float lo, float hi) { f32x2_t v = {lo, hi}; bf16x2_t b = __builtin_convertvector(v, bf16x2_t); return __builtin_bit_cast(unsigned, b); }
#define ATT_WAIT_BAR() asm volatile("s_waitcnt vmcnt(0) lgkmcnt(0)\n\ts_barrier" ::: "memory")
#define ATT_MFMA(a, b, c) __builtin_amdgcn_mfma_f32_32x32x16_bf16((a), (b), (c), 0, 0, 0)
__device__ __forceinline__ float max3f(float a, float b, float c) { float r; asm("v_max3_f32 %0, %1, %2, %3" : "=v"(r) : "v"(a), "v"(b), "v"(c)); return r; }
__device__ __forceinline__ float max2f(float a, float b) { float r; asm("v_max_f32_e32 %0, %1, %2" : "=v"(r) : "v"(a), "v"(b)); return r; }

__device__ __forceinline__ void qkt(f32x16& p0, f32x16& p1, lds_cptr kb, const bf16x8* qr, const f32x16& z) {
#pragma unroll
    for (int d0 = 0; d0 < 4; ++d0) {
        const bf16x8 b0 = *(const ATT_LAS bf16x8*)(kb + d0 * 2048);
        const bf16x8 b1 = *(const ATT_LAS bf16x8*)(kb + d0 * 2048 + 512);
        if (d0 == 0) { p0 = ATT_MFMA(b0, qr[0], z); p1 = ATT_MFMA(b1, qr[0], z); }
        else { p0 = ATT_MFMA(b0, qr[d0], p0); p1 = ATT_MFMA(b1, qr[d0], p1); } }
}
__device__ __forceinline__ void pv(f32x16* o, int vb, bf16x8 pa0, bf16x8 pa1, bf16x8 pa2, bf16x8 pa3) {
#pragma unroll
    for (int d0 = 0; d0 < 2; ++d0) { s16x4 lo[4], hi[4];
#pragma unroll
        for (int ks = 0; ks < 4; ++ks) {
            asm volatile("ds_read_b64_tr_b16 %0,%1 offset:%c2" : "=&v"(lo[ks]) : "v"(vb), "i"(d0 * 4096 + ks * 1024) : "memory");
            asm volatile("ds_read_b64_tr_b16 %0,%1 offset:%c2" : "=&v"(hi[ks]) : "v"(vb), "i"(d0 * 4096 + ks * 1024 + 512) : "memory"); }
        asm volatile("s_waitcnt lgkmcnt(0)" ::: "memory"); __builtin_amdgcn_sched_barrier(0);
#define ATT_PK(k) (bf16x8){lo[k][0], lo[k][1], lo[k][2], lo[k][3], hi[k][0], hi[k][1], hi[k][2], hi[k][3]}
        o[d0] = ATT_MFMA(pa0, ATT_PK(0), o[d0]);
        o[d0] = ATT_MFMA(pa1, ATT_PK(1), o[d0]);
        o[d0] = ATT_MFMA(pa2, ATT_PK(2), o[d0]);
        o[d0] = ATT_MFMA(pa3, ATT_PK(3), o[d0]);
#undef ATT_PK
    }
}


#define ATT_RD128(dst, addr, off) asm volatile("ds_read_b128 %0, %1 offset:%c2" : "=&v"(dst) : "v"(addr), "i"(off) : "memory")
#define ATT_RDTR(dst, addr, off) asm volatile("ds_read_b64_tr_b16 %0, %1 offset:%c2" : "=&v"(dst) : "v"(addr), "i"(off) : "memory")
template <bool DO_QK, bool DO_PV> __device__ __forceinline__ void mseg(f32x16& p0, f32x16& p1, f32x16* o, unsigned kaddr, unsigned vaddr, const bf16x8* qr, const f32x16& cin,
                                                                     bf16x8 pa0, bf16x8 pa1, bf16x8 pa2, bf16x8 pa3) {
    bf16x8 kf[4]; s16x4 vl[4], vh[4];
    if (DO_QK) { ATT_RD128(kf[0], kaddr, 0); ATT_RD128(kf[1], kaddr, 512); ATT_RD128(kf[2], kaddr, 2048); ATT_RD128(kf[3], kaddr, 2560); }
    if (DO_PV) { ATT_RDTR(vl[0], vaddr, 0); ATT_RDTR(vh[0], vaddr, 512); ATT_RDTR(vl[1], vaddr, 1024); ATT_RDTR(vh[1], vaddr, 1536);
                 ATT_RDTR(vl[2], vaddr, 2048); ATT_RDTR(vh[2], vaddr, 2560); ATT_RDTR(vl[3], vaddr, 3072); ATT_RDTR(vh[3], vaddr, 3584); }
    if (DO_QK) {
        if (DO_PV) asm volatile("s_waitcnt lgkmcnt(8)" : "+v"(kf[0]), "+v"(kf[1]), "+v"(kf[2]), "+v"(kf[3]) :: "memory");
        else asm volatile("s_waitcnt lgkmcnt(0)" : "+v"(kf[0]), "+v"(kf[1]), "+v"(kf[2]), "+v"(kf[3]) :: "memory");
        __builtin_amdgcn_sched_barrier(0);
        p0 = ATT_MFMA(kf[0], qr[0], cin); p1 = ATT_MFMA(kf[1], qr[0], cin);
        p0 = ATT_MFMA(kf[2], qr[1], p0);  p1 = ATT_MFMA(kf[3], qr[1], p1);
        __builtin_amdgcn_sched_barrier(0);
        ATT_RD128(kf[0], kaddr, 4096); ATT_RD128(kf[1], kaddr, 4608); ATT_RD128(kf[2], kaddr, 6144); ATT_RD128(kf[3], kaddr, 6656);
        asm volatile("s_waitcnt lgkmcnt(0)" : "+v"(kf[0]), "+v"(kf[1]), "+v"(kf[2]), "+v"(kf[3]), "+v"(vl[0]), "+v"(vh[0]), "+v"(vl[1]), "+v"(vh[1]), "+v"(vl[2]), "+v"(vh[2]), "+v"(vl[3]), "+v"(vh[3]) :: "memory");
        __builtin_amdgcn_sched_barrier(0);
        p0 = ATT_MFMA(kf[0], qr[2], p0);  p1 = ATT_MFMA(kf[1], qr[2], p1);
        p0 = ATT_MFMA(kf[2], qr[3], p0);  p1 = ATT_MFMA(kf[3], qr[3], p1);
        __builtin_amdgcn_sched_barrier(0);
    }
    if (DO_PV) {
        if (!DO_QK) asm volatile("s_waitcnt lgkmcnt(0)" : "+v"(vl[0]), "+v"(vh[0]), "+v"(vl[1]), "+v"(vh[1]), "+v"(vl[2]), "+v"(vh[2]), "+v"(vl[3]), "+v"(vh[3]) :: "memory");
        __builtin_amdgcn_sched_barrier(0);
#define ATT_PK2(l, h) (bf16x8){l[0], l[1], l[2], l[3], h[0], h[1], h[2], h[3]}
        o[0] = ATT_MFMA(pa0, ATT_PK2(vl[0], vh[0]), o[0]); o[0] = ATT_MFMA(pa1, ATT_PK2(vl[1], vh[1]), o[0]);
        o[0] = ATT_MFMA(pa2, ATT_PK2(vl[2], vh[2]), o[0]); o[0] = ATT_MFMA(pa3, ATT_PK2(vl[3], vh[3]), o[0]);
        __builtin_amdgcn_sched_barrier(0);
        ATT_RDTR(vl[0], vaddr, 4096); ATT_RDTR(vh[0], vaddr, 4608); ATT_RDTR(vl[1], vaddr, 5120); ATT_RDTR(vh[1], vaddr, 5632);
        ATT_RDTR(vl[2], vaddr, 6144); ATT_RDTR(vh[2], vaddr, 6656); ATT_RDTR(vl[3], vaddr, 7168); ATT_RDTR(vh[3], vaddr, 7680);
        asm volatile("s_waitcnt lgkmcnt(0)" : "+v"(vl[0]), "+v"(vh[0]), "+v"(vl[1]), "+v"(vh[1]), "+v"(vl[2]), "+v"(vh[2]), "+v"(vl[3]), "+v"(vh[3]) :: "memory");
        __builtin_amdgcn_sched_barrier(0);
        o[1] = ATT_MFMA(pa0, ATT_PK2(vl[0], vh[0]), o[1]); o[1] = ATT_MFMA(pa1, ATT_PK2(vl[1], vh[1]), o[1]);
        o[1] = ATT_MFMA(pa2, ATT_PK2(vl[2], vh[2]), o[1]); o[1] = ATT_MFMA(pa3, ATT_PK2(vl[3], vh[3]), o[1]);
#undef ATT_PK2
    }
}

template <int MODE> __device__ __forceinline__ void attn_unit(int b, int h, int qb, int t_lo, const bf16_t* Q, const bf16_t* __restrict__ K, const bf16_t* __restrict__ V, bf16_t* O, ATT_LAS unsigned char* lds, const int wid, const float kn2, const float bmax) {
    int lane_ = pg8::lane_id(); asm volatile("" : "+v"(lane_));
    const int lane = lane_, r32 = lane & 31, hi = lane >> 5;
    const long rowbase = (long)b * SEQ; const int q0 = qb * QB;
    const bf16_t* Qw = Q + (rowbase + q0 + wid * QBLK) * DM + h * 64;
    const bf16_t *Kh = K + rowbase * DM + h * 64, *Vh = V + rowbase * DM + h * 64;
    const unsigned lds0 = (unsigned)(uintptr_t)lds;
    ATT_LAS float* wsf = (ATT_LAS float*)(lds + LDS_WS) + wid * 64;
    const bf16_t* ksrc = Kh + (long)lane * DM + wid * 8;
    const bf16_t* vsrc = Vh + (long)(16 * (wid & 3) + (lane >> 2)) * DM + (wid >> 2) * 32 + (lane & 3) * 8;
    const unsigned kdst = lds0 + LDS_K + wid * 1024, vdst = lds0 + LDS_V + wid * 1024;
#define DMA_K(t, slot) glds16(ksrc + (long)(t) * KVBLK * DM, (unsigned)__builtin_amdgcn_readfirstlane(kdst + (slot)))
#define DMA_V(t, slot) glds16(vsrc + (long)(t) * KVBLK * DM, (unsigned)__builtin_amdgcn_readfirstlane(vdst + (slot)))
    const int vb0 = (int)(lds0 + LDS_V) + ((lane >> 4) & 1) * 32 + (lane & 3) * 8 + (4 * hi + ((lane & 15) >> 2)) * 64;
    const lds_cptr kp0 = (lds_cptr)lds + LDS_K + hi * 1024 + r32 * 16;
    const int NT = 4 * (qb + 1), n = NT - t_lo;
#define TILE(i) (MODE == 0 ? (NT - 1 - (i)) : (i))
#define SLOT(i) ((unsigned)((i) & 3) * SLOTB)
#define WSKIP(i) (2 * (TILE(i) - (NT - 4)) > wid)
    DMA_K(TILE(0), SLOT(0)); DMA_V(TILE(0), SLOT(0)); if (n > 1) { DMA_K(TILE(1), SLOT(1)); DMA_V(TILE(1), SLOT(1)); } if (n > 2) { DMA_K(TILE(2), SLOT(2)); DMA_V(TILE(2), SLOT(2)); } if (n > 3) DMA_K(TILE(3), SLOT(3));
    bf16x8 qr[4];
#pragma unroll
    for (int d0 = 0; d0 < 4; ++d0) qr[d0] = *reinterpret_cast<const bf16x8*>(&Qw[(long)r32 * DM + d0 * 16 + hi * 8]);
    asm volatile("" : "+v"(qr[0]), "+v"(qr[1]), "+v"(qr[2]), "+v"(qr[3]));
    const int qrel = wid * QBLK + r32;
    float ref;
    { float qn2 = 0.f;
#pragma unroll
      for (int d0 = 0; d0 < 4; ++d0)
#pragma unroll
          for (int e = 0; e < 8; ++e) { const float v = __uint_as_float((unsigned)(unsigned short)qr[d0][e] << 16); qn2 += v * v; }
      qn2 += pg8::xor_lane<32>(qn2);
      ref = sqrtf(qn2 * kn2) * 1.02f - 64.f;
      if (MODE == 0) ref -= ((const ATT_LAS float*)(lds + LDS_C))[q0 + qrel]; else ref += bmax; }
    unsigned selm = 0u; float tb31 = 0.f;
    if (MODE == 1) {
        f32x16 g = {};
        const lds_cptr kmp = (lds_cptr)lds + LDS_KM + (r32 & 15) * 128 + hi * 16;
#pragma unroll
        for (int d0 = 0; d0 < 4; ++d0) { const bf16x8 a = *(const ATT_LAS bf16x8*)(kmp + d0 * 32); g = ATT_MFMA(a, qr[d0], g); }
        ATT_LAS float* gs = (ATT_LAS float*)(lds + LDS_OST + wid * 4096);
#pragma unroll
        for (int i = 0; i < 8; ++i) gs[r32 * 16 + crow(i, hi)] = g[i];
        asm volatile("s_waitcnt lgkmcnt(0)" ::: "memory");
        float gv[16];
#pragma unroll
        for (int i = 0; i < 4; ++i) { const f32x4 t4 = *(const ATT_LAS f32x4*)(gs + r32 * 16 + 4 * i); gv[4 * i] = t4[0]; gv[4 * i + 1] = t4[1]; gv[4 * i + 2] = t4[2]; gv[4 * i + 3] = t4[3]; }
#pragma unroll
        for (int k = 0; k < 3; ++k) { float best = -INFINITY; int bi = -1;
#pragma unroll
            for (int n = 0; n < 15; ++n) { const bool ok = (n < qb) && !((selm >> n) & 1u) && (gv[n] > best); best = ok ? gv[n] : best; bi = ok ? n : bi; }
            if (bi >= 0) selm |= 1u << bi; }
        tb31 = ((const ATT_LAS float*)(lds + LDS_TB))[256 + 127];
        asm volatile("s_waitcnt lgkmcnt(0)" ::: "memory");
    }
    float l_reg = 0.f; f32x16 o[2]; o[0] = f32x16{}; o[1] = f32x16{};
    f32x16 negm;
#pragma unroll
    for (int r = 0; r < 16; ++r) negm[r] = -ref;
    asm volatile("" : "+v"(negm));
    const float NEG = -INFINITY;
    f32x16 p0, p1; u32x4 pw0 = {}, pw1 = {}, pw2 = {}, pw3 = {};
    const int grp = ATT_LOCKSTEP ? 2 : (wid >> 2);
    asm volatile("s_waitcnt vmcnt(0) lgkmcnt(0)\n\ts_barrier" ::: "memory");
    if (grp == 1) asm volatile("s_barrier" ::: "memory");
#define ATT_ITER(j, DOQK, DOPV) do { \
 \
        int nissue = 0; \
        if (j >= 0) { if (j + 4 < n) { DMA_K(TILE(j + 4), SLOT(j + 4)); ++nissue; } if (j + 3 < n) { DMA_V(TILE(j + 3), SLOT(j + 3)); ++nissue; } } \
        { \
            f32x16 cin = negm; \
            if (MODE == 1 && DOQK && TILE(j + 1) < 4 * qb - 2) { \
                const float lb = ((selm >> (TILE(j + 1) >> 2)) & 1u) ? tb31 : NEG; \
_Pragma("unroll") \
                for (int r = 0; r < 16; ++r) cin[r] = negm[r] + lb; } \
            if (DOQK) qkt(p0, p1, kp0 + SLOT(j + 1), qr, cin); \
            if (DOPV) pv(o, vb0 + (int)SLOT(j), __builtin_bit_cast(bf16x8, pw0), __builtin_bit_cast(bf16x8, pw1), __builtin_bit_cast(bf16x8, pw2), __builtin_bit_cast(bf16x8, pw3)); \
        } \
        asm volatile("s_waitcnt lgkmcnt(0)\n\ts_barrier" ::: "memory"); \
 \
        if (DOQK) { \
        const int t = TILE(j + 1); \
        const int kbase = KVBLK * t; \
        if (MODE == 0) { \
            const ATT_LAS float* cl = (const ATT_LAS float*)(lds + LDS_C) + kbase + 4 * hi; \
_Pragma("unroll") \
            for (int g4 = 0; g4 < 4; ++g4) { const f32x4 c0 = *(const ATT_LAS f32x4*)(cl + 8 * g4); \
_Pragma("unroll") \
                for (int e = 0; e < 4; ++e) p0[4 * g4 + e] -= c0[e]; } \
_Pragma("unroll") \
            for (int g4 = 0; g4 < 4; ++g4) { const f32x4 c1 = *(const ATT_LAS f32x4*)(cl + 8 * g4 + 32); \
_Pragma("unroll") \
                for (int e = 0; e < 4; ++e) p1[4 * g4 + e] -= c1[e]; } \
            if (t >= NT - 4) { const int kb = 64 * (t - (NT - 4)) + 4 * hi; \
_Pragma("unroll") \
                for (int r = 0; r < 16; ++r) { const int kv = kb + (r & 3) + 8 * (r >> 2); if (kv > qrel) p0[r] = NEG; if (kv + 32 > qrel) p1[r] = NEG; } } \
        } else { \
            const int nb = t >> 2; \
            if (t >= 4 * qb - 2) { \
 \
                const bool sel = (nb == qb) || ((selm >> nb) & 1u); \
                const int relb = q0 + qrel - kbase - 4 * hi; \
                const ATT_LAS float* pbp = (const ATT_LAS float*)(lds + LDS_TB) + (sel ? relb + 197 : 640); \
_Pragma("unroll") \
                for (int r = 0; r < 16; ++r) { const int off = (r & 3) + 8 * (r >> 2); p0[r] += pbp[59 - off]; p1[r] += pbp[27 - off]; } \
            } \
        } \
        float sacc = 0.f; \
_Pragma("unroll") \
        for (int r = 0; r < 16; ++r) { p0[r] = __builtin_amdgcn_exp2f(p0[r]); p1[r] = __builtin_amdgcn_exp2f(p1[r]); sacc += p0[r] + p1[r]; } \
        l_reg += sacc; \
        pw0 = (u32x4){cvtpk_s(p0[0], p0[1]), cvtpk_s(p0[2], p0[3]), cvtpk_s(p0[4], p0[5]), cvtpk_s(p0[6], p0[7])}; \
        pw1 = (u32x4){cvtpk_s(p0[8], p0[9]), cvtpk_s(p0[10], p0[11]), cvtpk_s(p0[12], p0[13]), cvtpk_s(p0[14], p0[15])}; \
        pw2 = (u32x4){cvtpk_s(p1[0], p1[1]), cvtpk_s(p1[2], p1[3]), cvtpk_s(p1[4], p1[5]), cvtpk_s(p1[6], p1[7])}; \
        pw3 = (u32x4){cvtpk_s(p1[8], p1[9]), cvtpk_s(p1[10], p1[11]), cvtpk_s(p1[12], p1[13]), cvtpk_s(p1[14], p1[15])}; \
        } \
 \
        if (nissue == 2) asm volatile("s_waitcnt vmcnt(2) lgkmcnt(0)\n\ts_barrier" ::: "memory"); \
        else if (nissue == 1) asm volatile("s_waitcnt vmcnt(1) lgkmcnt(0)\n\ts_barrier" ::: "memory"); \
        else asm volatile("s_waitcnt vmcnt(0) lgkmcnt(0)\n\ts_barrier" ::: "memory"); \
    } while (0)
    ATT_ITER(-1, true, false);
#pragma unroll 1
    for (int j = 0; j < n - 1; ++j) ATT_ITER(j, true, true);
    ATT_ITER(n - 1, false, true);
#undef ATT_ITER
    if (grp == 0) asm volatile("s_barrier" ::: "memory");
    { const int lane2 = pg8::lane_id(), r32b = lane2 & 31, hib = lane2 >> 5;
      ATT_LAS float* wsf2 = (ATT_LAS float*)(lds + LDS_WS) + wid * 64;
      { auto rr = __builtin_amdgcn_permlane32_swap(__float_as_uint(l_reg), __float_as_uint(l_reg), false, false); l_reg = __uint_as_float(rr[0]) + __uint_as_float(rr[1]); }
      if (hib == 0) wsf2[32 + r32b] = l_reg;
      asm volatile("s_waitcnt lgkmcnt(0)" ::: "memory");
      float rli[16];
#pragma unroll
      for (int r = 0; r < 16; ++r) rli[r] = __builtin_amdgcn_rcpf(wsf2[32 + crow(r, hib)]);
      bf16_t* Ow = O + ((long)b * SEQ + qb * QB + wid * QBLK) * DM + h * 64;
      ATT_LAS bf16_t* stg = (ATT_LAS bf16_t*)(lds + LDS_OST) + wid * 2048;
#pragma unroll
      for (int r = 0; r < 16; ++r) { const int orow = crow(r, hib);
#pragma unroll
          for (int d0 = 0; d0 < 2; ++d0) stg[orow * 64 + d0 * 32 + r32b] = (bf16_t)(cvtpk_s(o[d0][r] * rli[r], 0.f) & 0xffffu); }
      asm volatile("s_waitcnt lgkmcnt(0)" ::: "memory");
#pragma unroll
      for (int i = 0; i < 4; ++i) { const int row = i * 8 + (lane2 >> 3), ch = lane2 & 7; const u32x4 v = *(const ATT_LAS u32x4*)(stg + row * 64 + ch * 8); *(u32x4*)(Ow + (long)row * DM + ch * 8) = v; } }
    asm volatile("s_waitcnt lgkmcnt(0)" ::: "memory");
#undef DMA_K
#undef DMA_V
#undef TILE
#undef SLOT
#undef WSKIP
}
}
#define LAS __attribute__((address_space(3)))
#define SSQ(s) (ssq + (size_t)((s) & 3) * M * 16)
#define XB_TMO      128
#define XB_XCNT(j)  (256  + 64 * (j))
#define XB_XSUB(j)  (1280 + 64 * (j))
#define XB_XGEN(j)  (2304 + 64 * (j))
#define XB_TOP      3328
#define XB_TOPGEN   3392
#define XCD_BAR_WORDS 3456
#define XB_SPIN_CAP (1u << 18)

__device__ __forceinline__ unsigned xb_ld(unsigned* p)              { return __hip_atomic_load(p, __ATOMIC_RELAXED, __HIP_MEMORY_SCOPE_AGENT); }
__device__ __forceinline__ unsigned xb_add(unsigned* p, unsigned v) { return __hip_atomic_fetch_add(p, v, __ATOMIC_RELAXED, __HIP_MEMORY_SCOPE_AGENT); }
__device__ __forceinline__ unsigned xb_xcc_id() { return (unsigned)__builtin_amdgcn_s_getreg((3 << 11) | 20) & 0xFu; }
#define XB_SPIN(cond, bar) do { unsigned _sp = 0; while (cond) { __builtin_amdgcn_s_sleep(1); \
    if ((++_sp & 255u) == 0u) { if (xb_ld(&(bar)[XB_TMO])) break; if (_sp > XB_SPIN_CAP) { atomicAdd(&(bar)[XB_TMO], 1u); break; } } } } while (0)

struct XcdBarrier {
    unsigned* bar; unsigned x;
    volatile LAS unsigned* st;
};

__device__ __forceinline__ XcdBarrier xcd_barrier_post(unsigned* bar, volatile LAS unsigned* st, const bool is_t0) {
    XcdBarrier b; b.bar = bar; b.x = xb_xcc_id(); b.st = st;
    if (is_t0) (void)xb_add(&bar[XB_XCNT(b.x)], 1u);
    return b;
}
__device__ __forceinline__ void xcd_barrier_complete(unsigned* bar, unsigned x, unsigned& nloc, unsigned& nx) {
    const unsigned G = gridDim.x * gridDim.y * gridDim.z;
    unsigned sum, cnt, mine, sp = 0u;
    for (;;) {
        sum = 0u; cnt = 0u; mine = 0u;
#pragma unroll
        for (unsigned j = 0; j < 16; ++j) { const unsigned c = xb_ld(&bar[XB_XCNT(j)]); sum += c; cnt += (c > 0u) ? 1u : 0u; mine = (j == x) ? c : mine; }
        if (sum == G) break;
        __builtin_amdgcn_s_sleep(1);
        if ((++sp & 255u) == 0u) { if (xb_ld(&bar[XB_TMO])) break; if (sp > XB_SPIN_CAP) { atomicAdd(&bar[XB_TMO], 1u); break; } }
    }
    nloc = mine > 0u ? mine : 1u; nx = cnt > 0u ? cnt : 1u;
}

__device__ __forceinline__ void xcd_barrier(const XcdBarrier& b, const bool is_t0) {
    asm volatile("s_waitcnt vmcnt(0)" ::: "memory");
    __syncthreads();
    if (is_t0) {
        unsigned* bar = b.bar;
        __builtin_amdgcn_s_waitcnt(0);
        unsigned nloc = b.st[0], nx = b.st[1];
        if (nloc == 0u) { xcd_barrier_complete(bar, b.x, nloc, nx); b.st[0] = nloc; b.st[1] = nx; }
        const unsigned old = xb_add(&bar[XB_XSUB(b.x)], 1u);
        const unsigned gen = old / nloc;
        if (old + 1u == (gen + 1u) * nloc) {
            __builtin_amdgcn_fence(__ATOMIC_RELEASE, "agent");
            asm volatile("s_waitcnt vmcnt(0)" ::: "memory");
            const unsigned og = xb_add(&bar[XB_TOP], 1u);
            const unsigned tg = og / nx;
            if (og + 1u == (tg + 1u) * nx) xb_add(&bar[XB_TOPGEN], 1u);
            else XB_SPIN(xb_ld(&bar[XB_TOPGEN]) == tg, bar);
            __builtin_amdgcn_fence(__ATOMIC_ACQUIRE, "agent");
            xb_add(&bar[XB_XGEN(b.x)], 1u);
            asm volatile("s_waitcnt vmcnt(0)" ::: "memory");
        } else {
            XB_SPIN(xb_ld(&bar[XB_XGEN(b.x)]) == gen, bar);
            __builtin_amdgcn_fence(__ATOMIC_ACQUIRE, "agent");
            asm volatile("s_waitcnt vmcnt(0)" ::: "memory");
        }
    }
    __syncthreads();
}
typedef unsigned short bf16;
typedef unsigned v4u __attribute__((ext_vector_type(4)));
typedef float f32x4 __attribute__((ext_vector_type(4)));
typedef short bf16x8 __attribute__((ext_vector_type(8)));
#ifndef PROBE_DUP_FOX
#define PROBE_DUP_FOX 0
#endif
#ifndef PROBE_DUP_MOBA
#define PROBE_DUP_MOBA 0
#endif
#ifndef PROBE_DUP_SYNC
#define PROBE_DUP_SYNC 0
#endif
#define GRID_SYNC() do { XcdBarrier xb_; xb_.bar = (unsigned*)args.ws; xb_.x = xb_xcc_id(); xb_.st = (volatile LAS unsigned*)(lds + 131072) + 8; const bool t0_ = (wid_s == 0) && (pg8::lane_id() == 0); xcd_barrier(xb_, t0_); if (PROBE_DUP_SYNC) xcd_barrier(xb_, t0_); } while (0)
#ifndef SINGLE_ALIGN
#define SINGLE_ALIGN true
#endif
constexpr int NWAVES = 8;
constexpr int M = 16384, D = 1024, NH = 16, SEQ = 4096, FF = 2816, PD = 256, DEPTH = 4;
constexpr int LDS_BYTES = 147456;
constexpr size_t MiB = 1u << 20;
constexpr size_t WS_SSQ = 1 * MiB;
constexpr size_t WS_LOGF = 2 * MiB;
constexpr size_t WS_W = 4 * MiB, W_LAYER = 28 * MiB;
constexpr size_t WO_QKV = 0, WO_O = 3145728, WO_FI = 4194304, WO_FO = 9961472, WO_G = 12845056, WO_U = 13893632, WO_F = 14155776;
constexpr size_t WS_HB = 116 * MiB;
constexpr size_t WS_QO = 148 * MiB, WS_K = 180 * MiB, WS_V = 212 * MiB;
constexpr size_t WS_UP = 244 * MiB;
constexpr size_t WS_PB = 276 * MiB;
constexpr size_t WS_HB2 = 308 * MiB;
constexpr size_t WS_SSQ16 = 340 * MiB;
constexpr size_t WS_END = 344 * MiB;

__device__ __forceinline__ unsigned pk2(float lo, float hi) { return pg8::cvt_pk_bf16(lo, hi); }
__device__ __forceinline__ float wave_sum(float v) {
    v += pg8::xor_lane<1>(v); v += pg8::xor_lane<2>(v); v += pg8::xor_lane<4>(v); v += pg8::xor_lane<8>(v); v += pg8::xor_lane<16>(v); v += pg8::xor_lane<32>(v);
    return v;
}
struct TItem { const float* W; const float* gk; bf16* WT; int ldw, K, k0, n0, dst; };
__device__ __forceinline__ void titem_load(const TItem& T, f32x4 (&v)[8], int lane) {
    const int c4 = (lane & 7) * 4;
#pragma unroll
    for (int i = 0; i < 8; ++i) v[i] = *(const f32x4*)(T.W + (size_t)(T.k0 + 8 * i + (lane >> 3)) * T.ldw + T.n0 + c4);
}
__device__ __forceinline__ void titem_store(const TItem& T, f32x4 (&v)[8], LAS float* scr, int lane) {
    const int c4 = (lane & 7) * 4;
#pragma unroll
    for (int i = 0; i < 8; ++i) { if (T.gk != nullptr) v[i] = v[i] * T.gk[T.k0 + 8 * i + (lane >> 3)];
        LAS float* d = scr + (8 * i + (lane >> 3)) * 33 + c4; d[0] = v[i][0]; d[1] = v[i][1]; d[2] = v[i][2]; d[3] = v[i][3]; }
    asm volatile("s_waitcnt lgkmcnt(0)" ::: "memory");
    const int c = lane & 7;
#pragma unroll
    for (int j = 0; j < 4; ++j) { const int n = (lane >> 3) + 8 * j; const LAS float* s = scr + (8 * c) * 33 + n;
        v4u o; if (T.gk != nullptr) { o.x = pg8::pk_f16(s[0 * 33], s[1 * 33]); o.y = pg8::pk_f16(s[2 * 33], s[3 * 33]); o.z = pg8::pk_f16(s[4 * 33], s[5 * 33]); o.w = pg8::pk_f16(s[6 * 33], s[7 * 33]); }
        else { o.x = pk2(s[0 * 33], s[1 * 33]); o.y = pk2(s[2 * 33], s[3 * 33]); o.z = pk2(s[4 * 33], s[5 * 33]); o.w = pk2(s[6 * 33], s[7 * 33]); }
        *(v4u*)(T.WT + (size_t)(T.dst + n) * T.K + T.k0 + 8 * c) = o; }
    asm volatile("s_waitcnt lgkmcnt(0)" ::: "memory");
}

struct Args { const float* in[16]; float* out; unsigned char* ws; };

struct UpOrder { int c;
    __device__ __forceinline__ bool next(int i, pg8::Unit& u) const { if (c < 128 || i >= 2) return false; const int idx = (c - 128) * 2 + i; u.pm = idx >> 2; u.pn = idx & 3; return true; }
    __device__ __forceinline__ void a_ready(const pg8::Unit&) const {}
    __device__ __forceinline__ void done(const pg8::Unit&) const {}
};
template <int li> __device__ __forceinline__ void layer_fwd(const Args& args, LAS unsigned char* lds, const int wid_s) {
#define HCUR ((li & 1) ? HB : HB2)
#define HOTH ((li & 1) ? HB2 : HB)
        const int j = li >> 1; const bool fox = !(li & 1);
        {
        int lane_ = pg8::lane_id(); asm volatile("" : "+v"(lane_)); const int lane = lane_, wave = wid_s, tid = wave * 64 + lane;
        int bx_ = blockIdx.x; asm volatile("" : "+s"(bx_)); const int bx = bx_, G = gridDim.x;
        const int vcu = (G % 8 == 0) ? (bx % 8) * (G / 8) + bx / 8 : bx; const int gw = vcu * NWAVES + wave, NGW = G * NWAVES;
        (void)tid; (void)lane; (void)wave; (void)bx; (void)vcu; (void)gw; (void)NGW;
        int zs = 0; asm volatile("" : "+s"(zs));
        unsigned char* ws = args.ws + zs;
#define INP(k) (args.in[(k) + zs])
        float* out = args.out + zs;
        float* ssq = (float*)(ws + WS_SSQ16); float* logf_buf = (float*)(ws + WS_LOGF);
        bf16* HB = (bf16*)(ws + WS_HB); bf16* HB2 = (bf16*)(ws + WS_HB2); bf16* QO = (bf16*)(ws + WS_QO); bf16* KB = (bf16*)(ws + WS_K); bf16* VB = (bf16*)(ws + WS_V);
        bf16* ACT = (bf16*)(ws + WS_QO); bf16* UP = (bf16*)(ws + WS_UP); bf16* PB = (bf16*)(ws + WS_PB);
        (void)out; (void)ssq; (void)logf_buf; (void)HB; (void)HB2; (void)QO; (void)KB; (void)VB; (void)ACT; (void)UP; (void)PB;
        bf16* Wl = (bf16*)(ws + WS_W + (size_t)li * W_LAYER); const float* fox_b_f = INP(4);
            pg8::Gemm g{HCUR, Wl + WO_QKV, M, 3 * D, D}; pg8::StaticOrder S; S.init(M, 3 * D, G, bx);
            unsigned* nrm = (unsigned*)ws + 8192 + li * 2304;
            if (lane == 0) ((LAS int*)(lds + pg8::RSC_OFF))[wave * pg8::RSC_STRIDE] = 0;
            pg8::EpiQKV E{QO, (size_t)(WS_K - WS_QO) / 2, SSQ(3 * li), att::C2, fox ? nrm : nullptr, nrm + 2048, lds};
            pg8::gemm_phase<pg8::EpiQKV, pg8::StaticOrder, true, true, true>(lds, g, S, E, wid_s);
            if (fox) {
                const int fr = lane & 15, fq = lane >> 4; const float* ssq_in = SSQ(3 * li); const float* bfp = fox_b_f + j * 16;
                for (int task = gw; task < M / 16; task += NGW) {
                    const int row0 = task * 16; f32x4 acc = {0.f, 0.f, 0.f, 0.f};
                    const bf16* ap = HCUR + (size_t)(row0 + fr) * D + 8 * fq; const bf16* bp = Wl + WO_F + fr * 1024 + 8 * fq;
#pragma unroll 16
                    for (int kk = 0; kk < 32; ++kk) { const bf16x8 xw = *(const bf16x8*)(bp + 32 * kk), ya = *(const bf16x8*)(ap + 32 * kk);
                        acc = pg8::mma16<true>(xw, ya, acc); }
                    const int token = row0 + fr; const float rs = pg8::rstd_row(ssq_in, token); const int bb = token >> 12, s = token & 4095;
#pragma unroll
                    for (int e = 0; e < 4; ++e) { const int hh = 4 * fq + e; const float f = acc[e] * rs + bfp[hh];
                        const float lg = fminf(f, 0.f) - log1pf(expf(-fabsf(f))); logf_buf[(size_t)(bb * 16 + hh) * SEQ + s] = lg; }
                }
            }
        }
        GRID_SYNC();
        {
        int lane_ = pg8::lane_id(); asm volatile("" : "+v"(lane_)); const int lane = lane_, wave = wid_s, tid = wave * 64 + lane;
        int bx_ = blockIdx.x; asm volatile("" : "+s"(bx_)); const int bx = bx_, G = gridDim.x;
        const int vcu = (G % 8 == 0) ? (bx % 8) * (G / 8) + bx / 8 : bx; const int gw = vcu * NWAVES + wave, NGW = G * NWAVES;
        (void)tid; (void)lane; (void)wave; (void)bx; (void)vcu; (void)gw; (void)NGW;
        int zs = 0; asm volatile("" : "+s"(zs));
        unsigned char* ws = args.ws + zs;
#define INP(k) (args.in[(k) + zs])
        float* out = args.out + zs;
        float* ssq = (float*)(ws + WS_SSQ16); float* logf_buf = (float*)(ws + WS_LOGF);
        bf16* HB = (bf16*)(ws + WS_HB); bf16* HB2 = (bf16*)(ws + WS_HB2); bf16* QO = (bf16*)(ws + WS_QO); bf16* KB = (bf16*)(ws + WS_K); bf16* VB = (bf16*)(ws + WS_V);
        bf16* ACT = (bf16*)(ws + WS_QO); bf16* UP = (bf16*)(ws + WS_UP); bf16* PB = (bf16*)(ws + WS_PB);
        (void)out; (void)ssq; (void)logf_buf; (void)HB; (void)HB2; (void)QO; (void)KB; (void)VB; (void)ACT; (void)UP; (void)PB;
        const float* rel_tab = INP(8);
            const int bh = vcu >> 2, sidx = vcu & 3, b = bh >> 4, h = bh & 15;
            float kn2; { const unsigned* nkp = (const unsigned*)ws + 8192 + li * 2304 + 2048 + bh * 2; kn2 = __uint_as_float(nkp[0]) + __uint_as_float(nkp[1]); }
            if (fox) {
                unsigned* qctr = (unsigned*)ws + 24576 + j;
                LAS unsigned* uq = (LAS unsigned*)(lds + att::LDS_SC + 64);
                const float bmax = 0.f;
#pragma unroll 1
                for (;;) {
                    int zl = 0; asm volatile("" : "+v"(zl));
                    if ((wid_s == 0) && (pg8::lane_id() == 0)) uq[zl] = atomicAdd(qctr, 1u);
                    __syncthreads();
                    const unsigned u = (unsigned)__builtin_amdgcn_readfirstlane((int)uq[zl]);
                    if (u >= 1024u) break;
                    const int qb = 15 - (int)(u >> 6), bh = (int)(u & 63u), b = bh >> 4, h = bh & 15;
                    const int lnl = pg8::lane_id(); const int tdl = wid_s * 64 + lnl;
                    const int L = 256 * (qb + 1);
                    const unsigned* nrm_u = (const unsigned*)ws + 8192 + li * 2304;
                    const float kn2 = __uint_as_float(nrm_u[2048 + bh * 2]) + __uint_as_float(nrm_u[2048 + bh * 2 + 1]);
                    const float qn2u = __uint_as_float(nrm_u[(bh * 16 + qb) * 2]) + __uint_as_float(nrm_u[(bh * 16 + qb) * 2 + 1]);
                    float v[8];
                    if (8 * tdl < L) { const float* lf = logf_buf + (size_t)bh * SEQ + 8 * tdl; const f32x4 a = *(const f32x4*)lf, c = *(const f32x4*)(lf + 4);
                        v[0] = a[0]; v[1] = v[0] + a[1]; v[2] = v[1] + a[2]; v[3] = v[2] + a[3]; v[4] = v[3] + c[0]; v[5] = v[4] + c[1]; v[6] = v[5] + c[2]; v[7] = v[6] + c[3]; }
                    else {
#pragma unroll
                        for (int e = 0; e < 8; ++e) v[e] = 0.f; }
                    float incl = v[7];
#pragma unroll
                    for (int o = 1; o < 64; o <<= 1) { const float t = __int_as_float(__builtin_amdgcn_ds_bpermute(((lnl - o) & 63) << 2, __float_as_int(incl))); if (lnl >= o) incl += t; }
                    LAS float* wsum = (LAS float*)(lds + att::LDS_SC);
                    if (lnl == 63) wsum[tdl >> 6] = incl;
                    __syncthreads();
                    float basev = incl - v[7];
                    { int wv = wave; asm volatile("" : "+s"(wv));
#pragma unroll
                      for (int w = 0; w < 7; ++w) basev += (w < wv) ? wsum[w] : 0.f; }
                    LAS float* cl = (LAS float*)(lds + att::LDS_C) + 8 * tdl;
#pragma unroll
                    for (int e = 0; e < 8; ++e) cl[e] = (basev + v[e]) * att::LOG2E;
                    __syncthreads();
                    int t_lo = 0;
                    { const float B2 = sqrtf(qn2u * kn2) * 1.02f; const LAS float* cl2 = (const LAS float*)(lds + att::LDS_C);
                      const bool skip = (lnl < 4 * qb) && (2.f * B2 + (cl2[256 * qb] - cl2[64 * lnl + 63]) <= -152.f);
                      const unsigned long long msk = __ballot(skip); t_lo = msk ? 64 - __builtin_clzll(msk) : 0; t_lo = __builtin_amdgcn_readfirstlane(t_lo); }
                    att::attn_unit<0>(b, h, qb, t_lo, QO, KB, VB, QO, lds, wid_s, kn2, bmax);
                }
            } else {
                const bf16* Kh = KB + (size_t)b * SEQ * D + h * 64; const int ks = tid >> 3, ch = tid & 7;
                LAS float* red = (LAS float*)(lds + att::LDS_OST);
#pragma unroll 5
                for (int n = 0; n < 15; ++n) { float a8[8] = {0.f, 0.f, 0.f, 0.f, 0.f, 0.f, 0.f, 0.f};
#pragma unroll
                    for (int i = 0; i < 4; ++i) { const v4u w = *(const v4u*)(Kh + (size_t)(256 * n + ks + 64 * i) * D + ch * 8);
                        a8[0] += __uint_as_float(w.x << 16); a8[1] += __uint_as_float(w.x & 0xffff0000u); a8[2] += __uint_as_float(w.y << 16); a8[3] += __uint_as_float(w.y & 0xffff0000u);
                        a8[4] += __uint_as_float(w.z << 16); a8[5] += __uint_as_float(w.z & 0xffff0000u); a8[6] += __uint_as_float(w.w << 16); a8[7] += __uint_as_float(w.w & 0xffff0000u); }
#pragma unroll
                    for (int e = 0; e < 8; ++e) { a8[e] += pg8::xor_lane<8>(a8[e]); a8[e] += pg8::xor_lane<16>(a8[e]); a8[e] += pg8::xor_lane<32>(a8[e]); }
                    if (lane < 8) {
#pragma unroll
                        for (int e = 0; e < 8; ++e) red[(n * 8 + wave) * 64 + ch * 8 + e] = a8[e]; } }
                for (int idx = tid; idx < 704; idx += NWAVES * 64) { const int rel = idx - 256; float val = -INFINITY;
                    if (idx < 640 && rel >= 0) { const int n = rel < 127 ? rel : 127; int bucket;
                        if (n < 16) bucket = n; else { const float nf = (float)n; int large = 16 + (int)(logf(nf / 16.0f) / 2.0794415416798357f * 16.0f); bucket = large < 31 ? large : 31; }
                        val = rel_tab[bucket * 16 + h] * att::LOG2E; }
                    ((LAS float*)(lds + att::LDS_TB))[idx] = val; }
                __syncthreads();
                for (int idx = tid; idx < 1024; idx += NWAVES * 64) { const int n = idx >> 6, d = idx & 63; float s = 0.f;
                    if (n < 15) {
#pragma unroll
                        for (int w = 0; w < 8; ++w) s += red[(n * 8 + w) * 64 + d]; }
                    ((LAS bf16*)(lds + att::LDS_KM))[idx] = (bf16)(pk2(s * (1.0f / 256.0f), 0.f) & 0xffffu); }
                __syncthreads();
                float bmax = -INFINITY; for (int bk = 0; bk < 32; ++bk) bmax = fmaxf(bmax, rel_tab[bk * 16 + h] * att::LOG2E);
#pragma unroll 1
                for (int rep = 1 - PROBE_DUP_MOBA; rep < 2; ++rep)
#pragma unroll 1
                for (int i = 0; i < 4; ++i) { const int qb = (i == 0) ? sidx : (i == 1) ? 7 - sidx : (i == 2) ? 8 + sidx : 15 - sidx;
                    att::attn_unit<1>(b, h, qb, 0, QO, KB, VB, (rep == 0) ? UP : QO, lds, wid_s, kn2, bmax); }
            }
            asm volatile("s_waitcnt vmcnt(0)" ::: "memory");
        }
        GRID_SYNC();
        {
        int lane_ = pg8::lane_id(); asm volatile("" : "+v"(lane_)); const int lane = lane_, wave = wid_s, tid = wave * 64 + lane;
        int bx_ = blockIdx.x; asm volatile("" : "+s"(bx_)); const int bx = bx_, G = gridDim.x;
        const int vcu = (G % 8 == 0) ? (bx % 8) * (G / 8) + bx / 8 : bx; const int gw = vcu * NWAVES + wave, NGW = G * NWAVES;
        (void)tid; (void)lane; (void)wave; (void)bx; (void)vcu; (void)gw; (void)NGW;
        int zs = 0; asm volatile("" : "+s"(zs));
        unsigned char* ws = args.ws + zs;
#define INP(k) (args.in[(k) + zs])
        float* out = args.out + zs;
        float* ssq = (float*)(ws + WS_SSQ16); float* logf_buf = (float*)(ws + WS_LOGF);
        bf16* HB = (bf16*)(ws + WS_HB); bf16* HB2 = (bf16*)(ws + WS_HB2); bf16* QO = (bf16*)(ws + WS_QO); bf16* KB = (bf16*)(ws + WS_K); bf16* VB = (bf16*)(ws + WS_V);
        bf16* ACT = (bf16*)(ws + WS_QO); bf16* UP = (bf16*)(ws + WS_UP); bf16* PB = (bf16*)(ws + WS_PB);
        (void)out; (void)ssq; (void)logf_buf; (void)HB; (void)HB2; (void)QO; (void)KB; (void)VB; (void)ACT; (void)UP; (void)PB;
        bf16* Wl = (bf16*)(ws + WS_W + (size_t)li * W_LAYER); const float* x = INP(0); const float* ffn_g = INP(9);
            { pg8::Gemm g{QO, Wl + WO_O, M, D, D}; pg8::StaticOrder S; S.init(M, D, G, bx);
              pg8::EpiResid<0, false, false> E{HCUR, HOTH, SSQ(3 * li + 1), nullptr, nullptr}; (void)ffn_g; (void)x;
              pg8::gemm_phase<pg8::EpiResid<0, false, false>, pg8::StaticOrder, SINGLE_ALIGN, true>(lds, g, S, E, wid_s); }
        }
        GRID_SYNC();
        {
        int lane_ = pg8::lane_id(); asm volatile("" : "+v"(lane_)); const int lane = lane_, wave = wid_s, tid = wave * 64 + lane;
        int bx_ = blockIdx.x; asm volatile("" : "+s"(bx_)); const int bx = bx_, G = gridDim.x;
        const int vcu = (G % 8 == 0) ? (bx % 8) * (G / 8) + bx / 8 : bx; const int gw = vcu * NWAVES + wave, NGW = G * NWAVES;
        (void)tid; (void)lane; (void)wave; (void)bx; (void)vcu; (void)gw; (void)NGW;
        int zs = 0; asm volatile("" : "+s"(zs));
        unsigned char* ws = args.ws + zs;
#define INP(k) (args.in[(k) + zs])
        float* out = args.out + zs;
        float* ssq = (float*)(ws + WS_SSQ16); float* logf_buf = (float*)(ws + WS_LOGF);
        bf16* HB = (bf16*)(ws + WS_HB); bf16* HB2 = (bf16*)(ws + WS_HB2); bf16* QO = (bf16*)(ws + WS_QO); bf16* KB = (bf16*)(ws + WS_K); bf16* VB = (bf16*)(ws + WS_V);
        bf16* ACT = (bf16*)(ws + WS_QO); bf16* UP = (bf16*)(ws + WS_UP); bf16* PB = (bf16*)(ws + WS_PB);
        (void)out; (void)ssq; (void)logf_buf; (void)HB; (void)HB2; (void)QO; (void)KB; (void)VB; (void)ACT; (void)UP; (void)PB;
        bf16* Wl = (bf16*)(ws + WS_W + (size_t)li * W_LAYER);
            pg8::Gemm g{HOTH, Wl + WO_FI, M, 2 * FF, D}; pg8::StaticOrder S; S.init(M, 2 * FF, G, bx);
            if (lane == 0) ((LAS int*)(lds + pg8::RSC_OFF))[wave * pg8::RSC_STRIDE] = 0;
            pg8::EpiSwiGLU E{ACT, SSQ(3 * li + 1), lds};
            pg8::gemm_phase<pg8::EpiSwiGLU, pg8::StaticOrder, true, true, true>(lds, g, S, E, wid_s);
            { pg8::Gemm g2{PB + (size_t)li * M * PD, Wl + WO_U, M, D, PD}; UpOrder S2{bx}; pg8::EpiStoreBf16 E2{UP};
              pg8::gemm_phase<pg8::EpiStoreBf16, UpOrder, true, true>(lds, g2, S2, E2, wid_s); }
        }
        GRID_SYNC();
        {
        int lane_ = pg8::lane_id(); asm volatile("" : "+v"(lane_)); const int lane = lane_, wave = wid_s, tid = wave * 64 + lane;
        int bx_ = blockIdx.x; asm volatile("" : "+s"(bx_)); const int bx = bx_, G = gridDim.x;
        const int vcu = (G % 8 == 0) ? (bx % 8) * (G / 8) + bx / 8 : bx; const int gw = vcu * NWAVES + wave, NGW = G * NWAVES;
        (void)tid; (void)lane; (void)wave; (void)bx; (void)vcu; (void)gw; (void)NGW;
        int zs = 0; asm volatile("" : "+s"(zs));
        unsigned char* ws = args.ws + zs;
#define INP(k) (args.in[(k) + zs])
        float* out = args.out + zs;
        float* ssq = (float*)(ws + WS_SSQ16); float* logf_buf = (float*)(ws + WS_LOGF);
        bf16* HB = (bf16*)(ws + WS_HB); bf16* HB2 = (bf16*)(ws + WS_HB2); bf16* QO = (bf16*)(ws + WS_QO); bf16* KB = (bf16*)(ws + WS_K); bf16* VB = (bf16*)(ws + WS_V);
        bf16* ACT = (bf16*)(ws + WS_QO); bf16* UP = (bf16*)(ws + WS_UP); bf16* PB = (bf16*)(ws + WS_PB);
        (void)out; (void)ssq; (void)logf_buf; (void)HB; (void)HB2; (void)QO; (void)KB; (void)VB; (void)ACT; (void)UP; (void)PB;
        bf16* Wl = (bf16*)(ws + WS_W + (size_t)li * W_LAYER); const float* ple_g = INP(12);
            pg8::Gemm g{ACT, Wl + WO_FO, M, D, FF}; pg8::StaticOrder S; S.init(M, D, G, bx);
            pg8::EpiResid<0, false, false> E{HOTH, HCUR, SSQ(3 * li + 2), nullptr, nullptr}; (void)ple_g;
            pg8::gemm_phase<pg8::EpiResid<0, false, false>, pg8::StaticOrder, SINGLE_ALIGN, true>(lds, g, S, E, wid_s);
        }
        GRID_SYNC();
        {
        int lane_ = pg8::lane_id(); asm volatile("" : "+v"(lane_)); const int lane = lane_, wave = wid_s, tid = wave * 64 + lane;
        int bx_ = blockIdx.x; asm volatile("" : "+s"(bx_)); const int bx = bx_, G = gridDim.x;
        const int vcu = (G % 8 == 0) ? (bx % 8) * (G / 8) + bx / 8 : bx; const int gw = vcu * NWAVES + wave, NGW = G * NWAVES;
        (void)tid; (void)lane; (void)wave; (void)bx; (void)vcu; (void)gw; (void)NGW;
        int zs = 0; asm volatile("" : "+s"(zs));
        unsigned char* ws = args.ws + zs;
#define INP(k) (args.in[(k) + zs])
        float* out = args.out + zs;
        float* ssq = (float*)(ws + WS_SSQ16); float* logf_buf = (float*)(ws + WS_LOGF);
        bf16* HB = (bf16*)(ws + WS_HB); bf16* HB2 = (bf16*)(ws + WS_HB2); bf16* QO = (bf16*)(ws + WS_QO); bf16* KB = (bf16*)(ws + WS_K); bf16* VB = (bf16*)(ws + WS_V);
        bf16* ACT = (bf16*)(ws + WS_QO); bf16* UP = (bf16*)(ws + WS_UP); bf16* PB = (bf16*)(ws + WS_PB);
        (void)out; (void)ssq; (void)logf_buf; (void)HB; (void)HB2; (void)QO; (void)KB; (void)VB; (void)ACT; (void)UP; (void)PB;
        bf16* Wl = (bf16*)(ws + WS_W + (size_t)li * W_LAYER); const float* attn_g = INP(2); const float* fin_g = INP(15);
            pg8::Gemm g{HCUR, Wl + WO_G, M, D, D}; pg8::StaticOrder S; S.init(M, D, G, bx);
            (void)attn_g; (void)fin_g;
            pg8::EpiResid<1, false, false> E{HCUR, HOTH, SSQ(3 * li + 3), SSQ(3 * li + 2), UP}; (void)out;
            pg8::gemm_phase<pg8::EpiResid<1, false, false>, pg8::StaticOrder, SINGLE_ALIGN, true, true>(lds, g, S, E, wid_s);
        }
        GRID_SYNC();
}

__global__ void __launch_bounds__(NWAVES * 64, 2) fwd_megakernel(Args args) {
    extern __shared__ __attribute__((aligned(16))) unsigned char lds_raw[];
    LAS unsigned char* lds = (LAS unsigned char*)lds_raw;
    cg::grid_group grid = cg::this_grid();
    const int wid_s = __builtin_amdgcn_readfirstlane((int)threadIdx.x >> 6);
    if (wid_s == 0) ((LAS unsigned*)(lds + 131072))[pg8::lane_id()] = 0u;
    __syncthreads();
#ifndef PROBE_DUP_PRO
#define PROBE_DUP_PRO 0
#endif
#pragma unroll 1
    for (int prep = 0; prep < 1 + PROBE_DUP_PRO; ++prep) {
        int lane_ = pg8::lane_id(); asm volatile("" : "+v"(lane_)); const int lane = lane_, wave = wid_s, tid = wave * 64 + lane;
        int bx_ = blockIdx.x; asm volatile("" : "+s"(bx_)); const int bx = bx_, G = gridDim.x;
        const int vcu = (G % 8 == 0) ? (bx % 8) * (G / 8) + bx / 8 : bx; const int gw = vcu * NWAVES + wave, NGW = G * NWAVES;
        (void)tid; (void)lane; (void)wave; (void)bx; (void)vcu; (void)gw; (void)NGW;
        int zs = 0; asm volatile("" : "+s"(zs));
        unsigned char* ws = args.ws + zs;
#define INP(k) (args.in[(k) + zs])
        float* out = args.out + zs;
        float* ssq = (float*)(ws + WS_SSQ16); float* logf_buf = (float*)(ws + WS_LOGF);
        bf16* HB = (bf16*)(ws + WS_HB); bf16* HB2 = (bf16*)(ws + WS_HB2); bf16* QO = (bf16*)(ws + WS_QO); bf16* KB = (bf16*)(ws + WS_K); bf16* VB = (bf16*)(ws + WS_V);
        bf16* ACT = (bf16*)(ws + WS_QO); bf16* UP = (bf16*)(ws + WS_UP); bf16* PB = (bf16*)(ws + WS_PB);
        (void)out; (void)ssq; (void)logf_buf; (void)HB; (void)HB2; (void)QO; (void)KB; (void)VB; (void)ACT; (void)UP; (void)PB;
        const float* x = INP(0); const float* p = INP(1); const float* attn_g = INP(2); const float* fox_w_in = INP(3); const float* fox_w_o = INP(5);
        const float* moba_w_in = INP(6); const float* moba_w_o = INP(7); const float* ffn_w_in = INP(10); const float* ffn_w_out = INP(11); const float* ple_w_gate = INP(13); const float* ple_w_up = INP(14); const float* ffn_g = INP(9); const float* ple_g = INP(12);
        LAS float* scr = (LAS float*)(lds + wave * 16384);
        constexpr int IQ = 16 * 96, IO = 16 * 32, IFI = 16 * 176, IFO = 44 * 32, IG = 16 * 32, IU = 4 * 32, IL = IQ + IO + IFI + IFO + IG + IU;
#define DECODE_ITEM(itv, T) do { const int li_ = (itv) / IL; int r = (itv) % IL; const int j = li_ >> 1; const bool fox = !(li_ & 1); bf16* Wl = (bf16*)(ws + WS_W + (size_t)li_ * W_LAYER); \
            if (r < IQ) { const int kb = r / 96, nb = r % 96; T = TItem{fox ? fox_w_in + (size_t)j * 1024 * 3088 : moba_w_in + (size_t)j * 1024 * 3072, attn_g + li_ * 1024, Wl + WO_QKV, fox ? 3088 : 3072, 1024, 64 * kb, 32 * nb, 32 * nb}; break; } r -= IQ; \
            if (r < IO) { const int kb = r / 32, nb = r % 32; T = TItem{(fox ? fox_w_o : moba_w_o) + (size_t)j * 1024 * 1024, nullptr, Wl + WO_O, 1024, 1024, 64 * kb, 32 * nb, 32 * nb}; break; } r -= IO; \
            if (r < IFI) { const int kb = r / 176, nb = r % 176; const int c0 = 32 * nb, bj = c0 / 2816, jj = c0 % 2816; T = TItem{ffn_w_in + (size_t)li_ * 1024 * 5632, ffn_g + li_ * 1024, Wl + WO_FI, 5632, 1024, 64 * kb, c0, 256 * (jj / 128) + 128 * bj + (jj % 128)}; break; } r -= IFI; \
            if (r < IFO) { const int kb = r / 32, nb = r % 32; T = TItem{ffn_w_out + (size_t)li_ * 2816 * 1024, nullptr, Wl + WO_FO, 1024, 2816, 64 * kb, 32 * nb, 32 * nb}; break; } r -= IFO; \
            if (r < IG) { const int kb = r / 32, nb = r % 32; T = TItem{ple_w_gate + (size_t)li_ * 1024 * 1024, ple_g + li_ * 1024, Wl + WO_G, 1024, 1024, 64 * kb, 32 * nb, 32 * nb}; break; } r -= IG; \
            { const int kb = r / 32, nb = r % 32; T = TItem{ple_w_up + (size_t)li_ * 256 * 1024, nullptr, Wl + WO_U, 1024, 256, 64 * kb, 32 * nb, 32 * nb}; } } while (0)
        for (int it = gw; it < DEPTH * IL; it += 2 * NGW) {
            const bool hasB = it + NGW < DEPTH * IL;
            TItem TA, TB; DECODE_ITEM(it, TA); DECODE_ITEM(hasB ? it + NGW : it, TB);
            f32x4 va[8], vb[8]; titem_load(TA, va, lane); titem_load(TB, vb, lane);
            titem_store(TA, va, scr, lane); if (hasB) titem_store(TB, vb, scr, lane);
        }
#undef DECODE_ITEM
        const int gt = vcu * (NWAVES * 64) + tid, NGT = G * NWAVES * 64;
        for (int idx = gt; idx < 2 * 16384; idx += NGT) { const int j = idx >> 14, hh = (idx >> 10) & 15, k = idx & 1023;
            bf16* Wl = (bf16*)(ws + WS_W + (size_t)(2 * j) * W_LAYER);
            Wl[WO_F + hh * 1024 + k] = (bf16)(pg8::pk_f16(fox_w_in[(size_t)j * 1024 * 3088 + (size_t)k * 3088 + 3072 + hh] * attn_g[2 * j * 1024 + k], 0.f) & 0xffffu); }
        { constexpr size_t NP8 = (size_t)DEPTH * M * PD / 8;
          for (size_t idx = gt; idx < NP8; idx += (size_t)4 * NGT) { f32x4 a[4], b[4];
#pragma unroll
              for (int q = 0; q < 4; ++q) { const size_t i2 = idx + (size_t)q * NGT; if (i2 < NP8) { a[q] = *(const f32x4*)(p + i2 * 8); b[q] = *(const f32x4*)(p + i2 * 8 + 4); } }
#pragma unroll
              for (int q = 0; q < 4; ++q) { const size_t i2 = idx + (size_t)q * NGT; if (i2 < NP8) { v4u o; o.x = pk2(a[q][0], a[q][1]); o.y = pk2(a[q][2], a[q][3]); o.z = pk2(b[q][0], b[q][1]); o.w = pk2(b[q][2], b[q][3]); *(v4u*)(PB + i2 * 8) = o; } } } }
        for (int idx = gt; idx < 32768; idx += NGT) ((unsigned*)ws)[idx] = 0u;
        for (int row = gw; row < M; row += 2 * NGW) {
            const int row2 = row + NGW < M ? row + NGW : row;
            const f32x4* xr = (const f32x4*)(x + (size_t)row * D) + lane; const f32x4* xr2 = (const f32x4*)(x + (size_t)row2 * D) + lane;
            f32x4 v[4], w[4];
#pragma unroll
            for (int jx = 0; jx < 4; ++jx) { v[jx] = xr[64 * jx]; w[jx] = xr2[64 * jx]; }
            float s = 0.f, s2 = 0.f; unsigned long long* o8 = (unsigned long long*)(HB2 + (size_t)row * D) + lane; unsigned long long* o82 = (unsigned long long*)(HB2 + (size_t)row2 * D) + lane;
#pragma unroll
            for (int jx = 0; jx < 4; ++jx) { s += (v[jx][0] * v[jx][0] + v[jx][1] * v[jx][1]) + (v[jx][2] * v[jx][2] + v[jx][3] * v[jx][3]); s2 += (w[jx][0] * w[jx][0] + w[jx][1] * w[jx][1]) + (w[jx][2] * w[jx][2] + w[jx][3] * w[jx][3]);
                o8[64 * jx] = (unsigned long long)pg8::pk_f16(v[jx][0], v[jx][1]) | ((unsigned long long)pg8::pk_f16(v[jx][2], v[jx][3]) << 32);
                o82[64 * jx] = (unsigned long long)pg8::pk_f16(w[jx][0], w[jx][1]) | ((unsigned long long)pg8::pk_f16(w[jx][2], w[jx][3]) << 32); }
            s = wave_sum(s); s2 = wave_sum(s2);
            if (lane < 16) { ssq[(size_t)row * 16 + lane] = (lane == 0) ? s : 0.f; ssq[(size_t)row2 * 16 + lane] = (lane == 0) ? s2 : 0.f; } }
        (void)attn_g;
    }
    grid.sync();
    (void)xcd_barrier_post((unsigned*)args.ws, (volatile LAS unsigned*)(lds + 131072) + 8, (wid_s == 0) && (pg8::lane_id() == 0));

    layer_fwd<0>(args, lds, wid_s); layer_fwd<1>(args, lds, wid_s); layer_fwd<2>(args, lds, wid_s); layer_fwd<3>(args, lds, wid_s);
    {
        int lane_ = pg8::lane_id(); asm volatile("" : "+v"(lane_)); const int lane = lane_, wave = wid_s, tid = wave * 64 + lane;
        int bx_ = blockIdx.x; asm volatile("" : "+s"(bx_)); const int bx = bx_, G = gridDim.x;
        const int vcu = (G % 8 == 0) ? (bx % 8) * (G / 8) + bx / 8 : bx; const int gw = vcu * NWAVES + wave, NGW = G * NWAVES;
        (void)tid; (void)lane; (void)wave; (void)bx; (void)vcu; (void)gw; (void)NGW;
      float* out = args.out; const float* fin_g = args.in[15]; const float* ssq_f = (const float*)(args.ws + WS_SSQ16);
      const bf16* HF = (const bf16*)(args.ws + WS_HB2);
      const f32x4* gr = (const f32x4*)fin_g + lane; f32x4 gv[4];
#pragma unroll
      for (int jx = 0; jx < 4; ++jx) gv[jx] = gr[64 * jx];
      for (int row = gw; row < M; row += 2 * NGW) {
          const int row2 = row + NGW < M ? row + NGW : row;
          const unsigned long long* hr = (const unsigned long long*)(HF + (size_t)row * D) + lane; const unsigned long long* hr2 = (const unsigned long long*)(HF + (size_t)row2 * D) + lane;
          unsigned long long v[4], w[4];
#pragma unroll
          for (int jx = 0; jx < 4; ++jx) { v[jx] = hr[64 * jx]; w[jx] = hr2[64 * jx]; }
          const float rs = pg8::rstd_row(ssq_f, row), rs2 = pg8::rstd_row(ssq_f, row2);
          f32x4* xr = (f32x4*)(out + (size_t)row * D) + lane; f32x4* xr2 = (f32x4*)(out + (size_t)row2 * D) + lane;
#pragma unroll
          for (int jx = 0; jx < 4; ++jx) {
              const f32x4 a = {pg8::f16_lo((unsigned)v[jx]), pg8::f16_hi((unsigned)v[jx]), pg8::f16_lo((unsigned)(v[jx] >> 32)), pg8::f16_hi((unsigned)(v[jx] >> 32))};
              const f32x4 b = {pg8::f16_lo((unsigned)w[jx]), pg8::f16_hi((unsigned)w[jx]), pg8::f16_lo((unsigned)(w[jx] >> 32)), pg8::f16_hi((unsigned)(w[jx] >> 32))};
              xr[64 * jx] = a * rs * gv[jx]; if (row2 != row) xr2[64 * jx] = b * rs2 * gv[jx]; } } }
}

extern "C" void kernel_launch(void* const* d_in, const int* in_sizes, int n_in, void* d_out, int out_size, void* d_ws, size_t ws_size, hipStream_t stream) {
    static int grid = 0;
    if (grid == 0) {
        if (n_in != 16 || in_sizes[0] != M * D || out_size != M * D || ws_size < WS_END) { fprintf(stderr, "kernel_launch: unexpected shapes / workspace (n_in %d, ws %zu)\n", n_in, ws_size); grid = -1; return; }
        int dev = 0, cus = 0, per_cu = 0;
        hipGetDevice(&dev); hipDeviceGetAttribute(&cus, hipDeviceAttributeMultiprocessorCount, dev);
        if (hipFuncSetAttribute((const void*)fwd_megakernel, hipFuncAttributeMaxDynamicSharedMemorySize, LDS_BYTES) != hipSuccess) { fprintf(stderr, "kernel_launch: hipFuncSetAttribute failed\n"); grid = -1; return; }
        hipOccupancyMaxActiveBlocksPerMultiprocessor(&per_cu, (const void*)fwd_megakernel, NWAVES * 64, LDS_BYTES);
        (void)hipGetLastError();
        if (per_cu < 1) per_cu = 1;
        grid = cus;
        if (grid % 8 != 0 || grid > 256) grid = grid > 256 ? 256 : grid;
    }
    if (grid < 0) return;
    Args a{};
    for (int i = 0; i < 16; ++i) a.in[i] = (const float*)d_in[i];
    a.out = (float*)d_out; a.ws = (unsigned char*)d_ws;
    void* kargs[] = {&a};
    hipError_t e = hipLaunchCooperativeKernel((const void*)fwd_megakernel, dim3(grid), dim3(NWAVES * 64), kargs, LDS_BYTES, stream);
    if (e != hipSuccess) fprintf(stderr, "kernel_launch: cooperative launch failed: %s (grid %d)\n", hipGetErrorString(e), grid);
}
```

```cpp
#include <hip/hip_runtime.h>
#include <hip/hip_cooperative_groups.h>
#include <cstdio>
#include <cstdint>
#include <cmath>
namespace cg = cooperative_groups;
namespace pg8 {
#define PG8_LAS __attribute__((address_space(3)))
typedef unsigned short bf16_t;
typedef short bf16x8 __attribute__((ext_vector_type(8)));
typedef float f32x4 __attribute__((ext_vector_type(4)));
typedef unsigned u32x4 __attribute__((ext_vector_type(4)));
constexpr int BM = 256, BK = 64, HALF = 128, HTB = HALF * BK * 2  , STAGE_BYTES = 8 * HTB, NXCD = 8, WGM = 8;

__host__ __device__ __forceinline__ int lds_byte(int r, int c) { const int st = (r >> 4) * 2 + (c >> 5), rr = r & 15, cc = c & 31, ob = rr * 64 + cc * 2; return st * 1024 + (ob ^ (((ob >> 9) & 1) << 5)); }
__host__ __device__ __forceinline__ void stage_rc(int b, int& R, int& C) { const int st = b / 1024, sb = b % 1024, swz = sb ^ (((sb >> 9) & 1) << 5); R = (st >> 1) * 16 + swz / 64; C = (st & 1) * 32 + (swz % 64) / 2; }
__host__ __device__ __forceinline__ int perm32(int rho) { const int n = rho >> 4, i = rho & 15; return 8 * (i >> 2) + 4 * n + (i & 3); }

__device__ __forceinline__ int lane_id() { unsigned m = ~0u; asm volatile("" : "+s"(m)); return (int)__builtin_amdgcn_mbcnt_hi(m, __builtin_amdgcn_mbcnt_lo(m, 0u)); }
template <int MASK> __device__ __forceinline__ float xor_lane(float v) {
    if constexpr (MASK == 32) { auto rr = __builtin_amdgcn_permlane32_swap(__float_as_uint(v), __float_as_uint(v), false, false);
        const unsigned own = __float_as_uint(v); return __uint_as_float(rr[0] ^ rr[1] ^ own); }
    else return __int_as_float(__builtin_amdgcn_ds_swizzle(__float_as_int(v), (MASK << 10) | 0x1f));
}
typedef _Float16 f16x8 __attribute__((ext_vector_type(8)));
template <bool F16> __device__ __forceinline__ f32x4 mma16(bf16x8 a, bf16x8 b, f32x4 c) {
    if constexpr (F16) return __builtin_amdgcn_mfma_f32_16x16x32_f16(__builtin_bit_cast(f16x8, a), __builtin_bit_cast(f16x8, b), c, 0, 0, 0);
    else return __builtin_amdgcn_mfma_f32_16x16x32_bf16(a, b, c, 0, 0, 0);
}
struct Unit { int pm, pn; };
struct Gemm { const bf16_t* A; const bf16_t* Bt; int M, N, K; };

struct StaticOrder {
    int nM, nN, nwg, G, c;
    __host__ __device__ void init(int M, int N, int G_, int c_) { nM = M / BM; nN = N / BM; nwg = nM * nN; G = G_; c = c_; }
    __host__ __device__ bool next(int i, Unit& u) const {
        const long L = (long)i * G + c; if (L >= nwg) return false;
        int wgid = (int)L; { const int q = nwg / NXCD, r = nwg % NXCD, xcd = wgid % NXCD, off = wgid / NXCD; wgid = (xcd < r ? xcd * (q + 1) : r * (q + 1) + (xcd - r) * q) + off; }
        const int nig = WGM * nN, gid = wgid / nig, fm = gid * WGM, gsz = (nM - fm) < WGM ? (nM - fm) : WGM;
        u.pm = fm + ((wgid % nig) % gsz); u.pn = (wgid % nig) / gsz; return true;
    }
    __device__ __forceinline__ void a_ready(const Unit&) const {}
    __device__ __forceinline__ void done(const Unit&) const {}
};

typedef float f32x2cv __attribute__((ext_vector_type(2))); typedef __bf16 bf16x2cv __attribute__((ext_vector_type(2)));
__device__ __forceinline__ unsigned cvt_pk_bf16(float lo, float hi) { const f32x2cv v = {lo, hi}; const bf16x2cv b = __builtin_convertvector(v, bf16x2cv); return __builtin_bit_cast(unsigned, b); }
typedef float f32x2 __attribute__((ext_vector_type(2)));
constexpr float RMS_EPS = 1e-6f;
constexpr float LOG2E = 1.4426950408889634f;
typedef unsigned u32x2 __attribute__((ext_vector_type(2)));
__device__ __forceinline__ float rstd_of(float ssq) { return __builtin_amdgcn_rsqf(ssq * (1.0f / 1024.0f) + RMS_EPS); }
__device__ __forceinline__ float rstd_row(const float* ssq16, int row) { const f32x4* p = (const f32x4*)(ssq16 + (size_t)row * 16); const f32x4 a = p[0], b = p[1], c = p[2], d = p[3];
    return rstd_of((((a[0] + a[1]) + (a[2] + a[3])) + ((b[0] + b[1]) + (b[2] + b[3]))) + (((c[0] + c[1]) + (c[2] + c[3])) + ((d[0] + d[1]) + (d[2] + d[3])))); }
__device__ __forceinline__ float rstd_row4(const float* ssq16, int row, int fq) { const f32x4 a = *((const f32x4*)(ssq16 + (size_t)row * 16) + fq);
    float s = (a[0] + a[1]) + (a[2] + a[3]); s += xor_lane<16>(s); s += xor_lane<32>(s); return rstd_of(s); }

typedef _Float16 f16x2_t __attribute__((ext_vector_type(2)));
__device__ __forceinline__ unsigned pk_f16(float lo, float hi) { f16x2_t h; h.x = (_Float16)lo; h.y = (_Float16)hi; return __builtin_bit_cast(unsigned, h); }
__device__ __forceinline__ float f16_lo(unsigned w) { return (float)__builtin_bit_cast(f16x2_t, w).x; }
__device__ __forceinline__ float f16_hi(unsigned w) { return (float)__builtin_bit_cast(f16x2_t, w).y; }
__device__ __forceinline__ float sigmoid_f(float x) { return __builtin_amdgcn_rcpf(1.0f + __builtin_amdgcn_exp2f(-x * LOG2E)); }

#ifndef EPI_WT
#define EPI_WT 0
#endif
__device__ __forceinline__ void st16(void* p, u32x4 v) {
#if EPI_WT
    asm volatile("global_store_dwordx4 %0, %1, off sc1\n\ts_nop 1" :: "v"(p), "v"(v) : "memory");
#else
    *(u32x4*)p = v;
#endif
}
constexpr int RSC_OFF = 131072 + 1024, RSC_STRIDE = 132;
__device__ __forceinline__ void row_factors(float (&rsv)[8], const float* ssq, PG8_LAS unsigned char* ldsb, int pm, int row0, int wid, int fr, int fq) {
    PG8_LAS float* rc = (PG8_LAS float*)(ldsb + RSC_OFF) + wid * RSC_STRIDE;
    const int tag = __builtin_amdgcn_readfirstlane(((PG8_LAS int*)rc)[0]);
    if (tag == pm + 1) {
#pragma unroll
        for (int i = 0; i < 8; ++i) rsv[i] = rc[4 + i * 16 + fr];
    } else {
        f32x4 sq[8];
#pragma unroll
        for (int i = 0; i < 8; ++i) sq[i] = *((const f32x4*)(ssq + (size_t)(row0 + (i >> 2) * HALF + (i & 3) * 16) * 16) + fq);
#pragma unroll
        for (int i = 0; i < 8; ++i) { float s = (sq[i][0] + sq[i][1]) + (sq[i][2] + sq[i][3]); s += xor_lane<16>(s); s += xor_lane<32>(s); rsv[i] = rstd_of(s); if (fq == 0) rc[4 + i * 16 + fr] = rsv[i]; }
        if (fr == 0 && fq == 0) ((PG8_LAS int*)rc)[0] = pm + 1;
    }
}
struct EpiQKV {
    static constexpr bool PERM = true, AFTER_DRAIN = false;
    bf16_t* O; size_t split_stride; const float* ssq; float scale0; unsigned* nq; unsigned* nk; PG8_LAS unsigned char* ldsb;
    __device__ __forceinline__ void operator()(const f32x4 (&acc)[2][2][4][2], const Unit& u, int wr, int wc, int fr, int fq) const {
        asm volatile("" : "+v"(fr), "+v"(fq));
        const int row0 = u.pm * BM + wr * 64 + fr; int colt = u.pn * BM;
        const int t = colt >> 10; bf16_t* base = O + (size_t)t * split_stride; colt &= 1023; const float sc = (t == 0) ? scale0 : 1.f;
        const int col0 = colt + wc * 32 + 8 * fq;
        float rsv[8]; row_factors(rsv, ssq, ldsb, u.pm, row0, wr * 4 + wc, fr, fq);
#pragma unroll
        for (int i = 0; i < 8; ++i) rsv[i] *= sc;
        float mx[2] = {0.f, 0.f};
#pragma unroll
        for (int ai = 0; ai < 2; ++ai)
#pragma unroll
            for (int m = 0; m < 4; ++m) { const int row = row0 + ai * HALF + m * 16; const float rs = rsv[ai * 4 + m];
                bf16_t* rowp = base + (size_t)row * 1024 + col0;
#pragma unroll
                for (int bj = 0; bj < 2; ++bj) { const f32x4 v0 = acc[ai][bj][m][0] * rs, v1 = acc[ai][bj][m][1] * rs;
                    u32x4 w; w.x = cvt_pk_bf16(v0[0], v0[1]); w.y = cvt_pk_bf16(v0[2], v0[3]); w.z = cvt_pk_bf16(v1[0], v1[1]); w.w = cvt_pk_bf16(v1[2], v1[3]);
                    st16(rowp + bj * HALF, w);
                    if (t == 1 || (t == 0 && nq != nullptr)) { float s = (v0[0] * v0[0] + v0[1] * v0[1]) + (v0[2] * v0[2] + v0[3] * v0[3]) + (v1[0] * v1[0] + v1[1] * v1[1]) + (v1[2] * v1[2] + v1[3] * v1[3]);
                        s += xor_lane<16>(s); s += xor_lane<32>(s); mx[bj] = fmaxf(mx[bj], s); } } }
        if (t == 1 || (t == 0 && nq != nullptr)) {
#pragma unroll
            for (int bj = 0; bj < 2; ++bj) { float r = mx[bj]; r = fmaxf(r, xor_lane<1>(r)); r = fmaxf(r, xor_lane<2>(r)); r = fmaxf(r, xor_lane<4>(r)); r = fmaxf(r, xor_lane<8>(r));
                const int head = (colt + bj * HALF + wc * 32) >> 6, half = wc & 1, bb = u.pm >> 4, qb = u.pm & 15;
                if (fr == 0 && fq == 0) { if (t == 0) atomicMax(nq + ((bb * 16 + head) * 16 + qb) * 2 + half, __float_as_uint(r)); else atomicMax(nk + (bb * 16 + head) * 2 + half, __float_as_uint(r)); } }
        }
    }
};
struct EpiSwiGLU {
    static constexpr bool PERM = true, AFTER_DRAIN = false;
    bf16_t* O; const float* ssq; PG8_LAS unsigned char* ldsb;
    __device__ __forceinline__ void operator()(const f32x4 (&acc)[2][2][4][2], const Unit& u, int wr, int wc, int fr, int fq) const {
        asm volatile("" : "+v"(fr), "+v"(fq));
        const int row0 = u.pm * BM + wr * 64 + fr; const int col0 = u.pn * HALF + wc * 32 + 8 * fq;
        float rsv[8]; row_factors(rsv, ssq, ldsb, u.pm, row0, wr * 4 + wc, fr, fq);
#pragma unroll
        for (int ai = 0; ai < 2; ++ai)
#pragma unroll
            for (int m = 0; m < 4; ++m) { const int row = row0 + ai * HALF + m * 16; const float rs = rsv[ai * 4 + m];
                float a[8];
#pragma unroll
                for (int n = 0; n < 2; ++n)
#pragma unroll
                    for (int e = 0; e < 4; ++e) { const float g = acc[ai][0][m][n][e] * rs, uu = acc[ai][1][m][n][e] * rs; a[4 * n + e] = g * sigmoid_f(g) * uu; }
                u32x4 w; w.x = cvt_pk_bf16(a[0], a[1]); w.y = cvt_pk_bf16(a[2], a[3]); w.z = cvt_pk_bf16(a[4], a[5]); w.w = cvt_pk_bf16(a[6], a[7]);
                st16(O + (size_t)row * 2816 + col0, w); }
    }
};
template <int MODE, bool BASEF32, bool OUTF32> struct EpiResid {
    static constexpr bool PERM = true, AFTER_DRAIN = false;
    const void* base; void* outp; float* ssq_out; const float* ssq_in; const bf16_t* up;
    __device__ __forceinline__ void operator()(const f32x4 (&acc)[2][2][4][2], const Unit& u, int wr, int wc, int fr, int fq) const {
        asm volatile("" : "+v"(fr), "+v"(fq));
        const int col0 = u.pn * BM + wc * 32 + 8 * fq;
        constexpr int PF = BASEF32 ? 2 : 4;
#pragma unroll
        for (int g = 0; g < 8 / PF; ++g) {
            u32x4 bw[PF][2], bw2[PF][2], uw[PF][2]; f32x4 sq[PF];
#pragma unroll
            for (int i = 0; i < PF; ++i) { const int gi = g * PF + i, ai = gi >> 2, m = gi & 3; const int row = u.pm * BM + ai * HALF + wr * 64 + m * 16 + fr; const size_t off = (size_t)row * 1024 + col0;
                if (MODE == 1) sq[i] = *((const f32x4*)(ssq_in + (size_t)row * 16) + fq);
#pragma unroll
                for (int bj = 0; bj < 2; ++bj) { const size_t o2 = off + bj * HALF;
                    if (BASEF32) { bw[i][bj] = *(const u32x4*)((const float*)base + o2); bw2[i][bj] = *(const u32x4*)((const float*)base + o2 + 4); }
                    else bw[i][bj] = *(const u32x4*)((const bf16_t*)base + o2);
                    if (MODE == 1) uw[i][bj] = *(const u32x4*)(up + o2); } }
#pragma unroll
            for (int i = 0; i < PF; ++i) { const int gi = g * PF + i, ai = gi >> 2, m = gi & 3; const int row = u.pm * BM + ai * HALF + wr * 64 + m * 16 + fr; const size_t off = (size_t)row * 1024 + col0;
                float rs = 1.f; if (MODE == 1) { float s4 = (sq[i][0] + sq[i][1]) + (sq[i][2] + sq[i][3]); s4 += xor_lane<16>(s4); s4 += xor_lane<32>(s4); rs = rstd_of(s4); }
                float s = 0.f;
#pragma unroll
                for (int bj = 0; bj < 2; ++bj) { const size_t o2 = off + bj * HALF;
                    float bs[8];
                    if (BASEF32) {
#pragma unroll
                        for (int q = 0; q < 4; ++q) { bs[q] = __uint_as_float(bw[i][bj][q]); bs[4 + q] = __uint_as_float(bw2[i][bj][q]); } }
                    else {
#pragma unroll
                        for (int q = 0; q < 4; ++q) { bs[2 * q] = f16_lo(bw[i][bj][q]); bs[2 * q + 1] = f16_hi(bw[i][bj][q]); } }
                    float a[8];
#pragma unroll
                    for (int n = 0; n < 2; ++n)
#pragma unroll
                        for (int e2 = 0; e2 < 4; ++e2) a[4 * n + e2] = acc[ai][bj][m][n][e2];
                    if (MODE == 1) {
#pragma unroll
                        for (int q = 0; q < 4; ++q) { a[2 * q] = sigmoid_f(a[2 * q] * rs) * __uint_as_float(uw[i][bj][q] << 16); a[2 * q + 1] = sigmoid_f(a[2 * q + 1] * rs) * __uint_as_float(uw[i][bj][q] & 0xffff0000u); } }
                    float hn[8];
#pragma unroll
                    for (int q = 0; q < 8; ++q) { hn[q] = bs[q] + a[q]; s += hn[q] * hn[q]; }
                    if (OUTF32) { *(f32x4*)((float*)outp + o2) = (f32x4){hn[0], hn[1], hn[2], hn[3]}; *(f32x4*)((float*)outp + o2 + 4) = (f32x4){hn[4], hn[5], hn[6], hn[7]}; }
                    else { u32x4 w; w.x = pk_f16(hn[0], hn[1]); w.y = pk_f16(hn[2], hn[3]); w.z = pk_f16(hn[4], hn[5]); w.w = pk_f16(hn[6], hn[7]); st16((bf16_t*)outp + o2, w); } }
                s += xor_lane<16>(s); s += xor_lane<32>(s);
                if (fq == 0) ssq_out[(size_t)row * 16 + u.pn * 4 + wc] = s; }
        }
    }
};
struct EpiStoreBf16 {
    static constexpr bool PERM = false, AFTER_DRAIN = false;
    bf16_t* O;
    __device__ __forceinline__ void operator()(const f32x4 (&acc)[2][2][4][2], const Unit& u, int wr, int wc, int fr, int fq) const {
        asm volatile("" : "+v"(fr), "+v"(fq));
        const int col0 = u.pn * BM + wc * 32 + 4 * fq;
#pragma unroll
        for (int ai = 0; ai < 2; ++ai)
#pragma unroll
            for (int m = 0; m < 4; ++m) { const int row = u.pm * BM + ai * HALF + wr * 64 + m * 16 + fr; const size_t off = (size_t)row * 1024 + col0;
#pragma unroll
                for (int bj = 0; bj < 2; ++bj)
#pragma unroll
                    for (int n = 0; n < 2; ++n) { const f32x4 a = acc[ai][bj][m][n]; u32x2 w; w.x = cvt_pk_bf16(a[0], a[1]); w.y = cvt_pk_bf16(a[2], a[3]); *(u32x2*)(hb_ptr(off + bj * HALF + n * 16)) = w; } }
    }
    __device__ __forceinline__ bf16_t* hb_ptr(size_t o) const { return O + o; }
};
template <class Epi, class Sched, bool ALIGN_EPI = false, bool SP2 = false, bool F16 = false>
__device__ __forceinline__ void gemm_phase(PG8_LAS unsigned char* lds, const Gemm g, const Sched& S, const Epi& E, const int wid_in) {
    int lane_ = lane_id(); asm volatile("" : "+v"(lane_));
    const int wid = wid_in, lane = lane_, tid = wid * 64 + lane, wr = wid >> 2, wc = wid & 3, fr = lane & 15, fq = lane >> 4;
    const int K = g.K, nt = K / BK;
    unsigned voffA[2], voffB[2];
#pragma unroll
    for (int i = 0; i < 2; ++i) { int R, C; stage_rc(tid * 16 + i * 8192, R, C); const int Rb = Epi::PERM ? ((R & ~31) + perm32(R & 31)) : R;
        voffA[i] = (unsigned)(R * K + C) * 2u; voffB[i] = (unsigned)(Rb * K + C) * 2u; }
    const size_t kstep = (size_t)(BK * 2);
    const size_t hstep = (size_t)HALF * K * 2;
    const size_t tstep = 2 * hstep;
    const unsigned ldsw = (unsigned)wid * 1024u;
    const int aoff = lds_byte(wr * 64 + fr, fq * 8), boff = lds_byte(wc * 32 + fr, fq * 8);
#define PG8_SA(b, h) (((b) * 2 + (h)) * HTB)
#define PG8_SB(b, h) ((4 + (b) * 2 + (h)) * HTB)
#define PG8_STAGE(bufoff, gbase, voff) do { _Pragma("unroll") for (int _i = 0; _i < 2; ++_i) \
        __builtin_amdgcn_global_load_lds((const unsigned*)((const char*)(gbase) + (voff)[_i]), (PG8_LAS unsigned*)(lds + (bufoff) + ldsw + _i * 8192), 16, 0, 0); } while (0)
#define PG8_LDA(dst, b, h) do { _Pragma("unroll") for (int m = 0; m < 4; ++m) _Pragma("unroll") for (int k = 0; k < 2; ++k) dst[m][k] = *(const PG8_LAS bf16x8*)(lds + PG8_SA(b, h) + aoff + m * 2048 + k * 1024); } while (0)
#define PG8_LDB(dst, b, h) do { _Pragma("unroll") for (int n = 0; n < 2; ++n) _Pragma("unroll") for (int k = 0; k < 2; ++k) dst[n][k] = *(const PG8_LAS bf16x8*)(lds + PG8_SB(b, h) + boff + n * 2048 + k * 1024); } while (0)
#define PG8_MMA(ai, bj, At, Bt) do { __builtin_amdgcn_s_setprio(1); _Pragma("unroll") for (int m = 0; m < 4; ++m) _Pragma("unroll") for (int n = 0; n < 2; ++n) _Pragma("unroll") for (int k = 0; k < 2; ++k) \
        acc[ai][bj][m][n] = mma16<F16>(Bt[n][k], At[m][k], acc[ai][bj][m][n]); __builtin_amdgcn_s_setprio(0); } while (0)
#define PG8_WAIT_V(n) asm volatile("s_waitcnt vmcnt(" #n ")" ::: "memory")
#define PG8_WAIT_L(n) asm volatile("s_waitcnt lgkmcnt(" #n ")" ::: "memory")
#define PG8_BAR __builtin_amdgcn_s_barrier()
#define PG8_SCHED __builtin_amdgcn_sched_barrier(0)
    Unit cur, nxt; int ui = 0;
    if (!S.next(0, cur)) return;
    f32x4 acc[2][2][4][2];
#pragma unroll
    for (int a = 0; a < 2; ++a)
#pragma unroll
        for (int b = 0; b < 2; ++b)
#pragma unroll
            for (int m = 0; m < 4; ++m)
#pragma unroll
                for (int n = 0; n < 2; ++n) acc[a][b][m][n] = (f32x4){0.f, 0.f, 0.f, 0.f};
    bf16x8 At[4][2], B0[2][2], B1[2][2];
    const char* cA = (const char*)g.A + (size_t)cur.pm * tstep; const char* cB = (const char*)g.Bt + (size_t)cur.pn * tstep;
    S.a_ready(cur);
    if constexpr (SP2) {
        PG8_STAGE(PG8_SB(0, 0), cB, voffB); PG8_STAGE(PG8_SB(0, 1), cB + hstep, voffB); PG8_STAGE(PG8_SA(0, 0), cA, voffA); PG8_STAGE(PG8_SA(0, 1), cA + hstep, voffA);
        if (wr == 1) PG8_BAR;
        PG8_WAIT_V(2); PG8_BAR;
        PG8_STAGE(PG8_SB(1, 0), cB + kstep, voffB); PG8_STAGE(PG8_SA(1, 0), cA + kstep, voffA); PG8_STAGE(PG8_SB(1, 1), cB + hstep + kstep, voffB);
        PG8_WAIT_V(6); PG8_BAR;
    } else {
        PG8_STAGE(PG8_SB(0, 0), cB, voffB); PG8_STAGE(PG8_SA(0, 0), cA, voffA); PG8_STAGE(PG8_SB(0, 1), cB + hstep, voffB); PG8_STAGE(PG8_SA(0, 1), cA + hstep, voffA);
        if (wr == 1) PG8_BAR;
        PG8_WAIT_V(4); PG8_BAR;
        PG8_STAGE(PG8_SB(1, 0), cB + kstep, voffB); PG8_STAGE(PG8_SA(1, 0), cA + kstep, voffA); PG8_STAGE(PG8_SB(1, 1), cB + hstep + kstep, voffB);
        PG8_WAIT_V(6); PG8_BAR;
    }
    for (;;) {
        const bool has_next = S.next(ui + 1, nxt);
        const char* nA = has_next ? (const char*)g.A + (size_t)nxt.pm * tstep : cA; const char* nB = has_next ? (const char*)g.Bt + (size_t)nxt.pn * tstep : cB;
        for (int t = 0; t < nt; t += 2) {
            const bool last = (t == nt - 2);
            const char* a1 = cA + (size_t)(t + 1) * kstep;
            const char* a2 = last ? nA : cA + (size_t)(t + 2) * kstep; const char* b2 = last ? nB : cB + (size_t)(t + 2) * kstep;
            const char* a3 = a2 + kstep; const char* b3 = b2 + kstep;
            if (last && has_next) S.a_ready(nxt);
            if constexpr (SP2) {
            PG8_LDB(B0, 0, 0); PG8_LDB(B1, 0, 1); PG8_SCHED; PG8_LDA(At, 0, 0); PG8_STAGE(PG8_SA(1, 1), a1 + hstep, voffA);
            PG8_WAIT_V(8); PG8_WAIT_L(0); PG8_BAR; PG8_MMA(0, 0, At, B0); PG8_MMA(0, 1, At, B1); PG8_BAR; PG8_SCHED;
            PG8_LDA(At, 0, 1); PG8_STAGE(PG8_SB(0, 0), b2, voffB); PG8_STAGE(PG8_SB(0, 1), b2 + hstep, voffB); PG8_STAGE(PG8_SA(0, 0), a2, voffA);
            PG8_WAIT_V(8); PG8_WAIT_L(0); PG8_BAR; PG8_MMA(1, 0, At, B0); PG8_MMA(1, 1, At, B1); PG8_BAR; PG8_SCHED;
            PG8_LDB(B0, 1, 0); PG8_LDB(B1, 1, 1); PG8_SCHED; PG8_LDA(At, 1, 0); PG8_STAGE(PG8_SA(0, 1), a2 + hstep, voffA);
            PG8_WAIT_V(8); PG8_WAIT_L(0); PG8_BAR; PG8_MMA(0, 0, At, B0); PG8_MMA(0, 1, At, B1); PG8_BAR; PG8_SCHED;
            PG8_LDA(At, 1, 1); PG8_STAGE(PG8_SB(1, 0), b3, voffB); PG8_STAGE(PG8_SB(1, 1), b3 + hstep, voffB); PG8_STAGE(PG8_SA(1, 0), a3, voffA);
            PG8_WAIT_V(8); PG8_WAIT_L(0); PG8_BAR; PG8_MMA(1, 0, At, B0); PG8_MMA(1, 1, At, B1); PG8_BAR; PG8_SCHED;
            } else {
            PG8_LDB(B0, 0, 0); PG8_SCHED; PG8_LDA(At, 0, 0); PG8_STAGE(PG8_SA(1, 1), a1 + hstep, voffA);
            PG8_WAIT_L(8); PG8_BAR; PG8_WAIT_L(0); PG8_MMA(0, 0, At, B0); PG8_BAR; PG8_SCHED;
            PG8_LDB(B1, 0, 1); PG8_STAGE(PG8_SB(0, 0), b2, voffB);
            PG8_BAR; PG8_WAIT_L(0); PG8_MMA(0, 1, At, B1); PG8_BAR;
            PG8_LDA(At, 0, 1); PG8_STAGE(PG8_SA(0, 0), a2, voffA);
            PG8_BAR; PG8_WAIT_L(0); PG8_MMA(1, 0, At, B0); PG8_BAR; PG8_SCHED;
            PG8_STAGE(PG8_SB(0, 1), b2 + hstep, voffB);
            PG8_WAIT_V(6); PG8_BAR; PG8_MMA(1, 1, At, B1); PG8_BAR;
            PG8_LDB(B0, 1, 0); PG8_SCHED; PG8_LDA(At, 1, 0); PG8_STAGE(PG8_SA(0, 1), a2 + hstep, voffA);
            PG8_WAIT_L(8); PG8_BAR; PG8_WAIT_L(0); PG8_MMA(0, 0, At, B0); PG8_BAR; PG8_SCHED;
            PG8_LDB(B1, 1, 1); PG8_STAGE(PG8_SB(1, 0), b3, voffB);
            PG8_BAR; PG8_WAIT_L(0); PG8_MMA(0, 1, At, B1); PG8_BAR;
            PG8_LDA(At, 1, 1); PG8_STAGE(PG8_SA(1, 0), a3, voffA);
            PG8_BAR; PG8_WAIT_L(0); PG8_MMA(1, 0, At, B0); PG8_BAR; PG8_SCHED;
            PG8_STAGE(PG8_SB(1, 1), b3 + hstep, voffB);
            PG8_WAIT_V(6); PG8_BAR; PG8_MMA(1, 1, At, B1); PG8_BAR;
            }
        }
        if constexpr (ALIGN_EPI) { if (wr == 0) PG8_BAR; }
        if constexpr (!Epi::AFTER_DRAIN) { E(acc, cur, wr, wc, fr, fq); S.done(cur); }
        if (!has_next) break;
#pragma unroll
        for (int a = 0; a < 2; ++a)
#pragma unroll
            for (int b = 0; b < 2; ++b)
#pragma unroll
                for (int m = 0; m < 4; ++m)
#pragma unroll
                    for (int n = 0; n < 2; ++n) acc[a][b][m][n] = (f32x4){0.f, 0.f, 0.f, 0.f};
        cur = nxt; cA = nA; cB = nB; ++ui;
        if constexpr (ALIGN_EPI) { if (wr == 1) PG8_BAR; }
    }
    PG8_WAIT_V(0);
    if constexpr (!ALIGN_EPI) { if (wr == 0) PG8_BAR; }
    PG8_BAR;
    if constexpr (Epi::AFTER_DRAIN) { E.fused(acc, cur, wr, wc, fr, fq, lds, wid, lane); S.done(cur); }
#undef PG8_SA
#undef PG8_SB
#undef PG8_STAGE
#undef PG8_LDA
#undef PG8_LDB
#undef PG8_MMA
#undef PG8_WAIT_V
#undef PG8_WAIT_L
#undef PG8_BAR
#undef PG8_SCHED
}
}
#ifndef ATT_LOCKSTEP
#define ATT_LOCKSTEP 0
#endif
namespace att {
#define ATT_LAS __attribute__((address_space(3)))
typedef unsigned short bf16_t;
using bf16x8 = __attribute__((ext_vector_type(8))) short;
using s16x4 = __attribute__((ext_vector_type(4))) short;
using f32x16 = __attribute__((ext_vector_type(16))) float;
using f32x4 = __attribute__((ext_vector_type(4))) float;
using u32x4 = __attribute__((ext_vector_type(4))) unsigned;
constexpr int SEQ = 4096, DM = 1024, NW = 8, QBLK = 32, QB = 256, KVBLK = 64;
constexpr int SLOTB = 8192, LDS_K = 0, LDS_V = 4 * SLOTB, LDS_WS = 8 * SLOTB, LDS_OST = LDS_WS + NW * 256, LDS_C = LDS_OST + NW * 4096, LDS_KM = LDS_C + 16384, LDS_TB = LDS_KM + 2048,
              LDS_SC = LDS_TB + 3072, LDS_END = LDS_SC + 256;
constexpr float LOG2E = 1.4426950408889634f;
constexpr float C2 = 0.125f * LOG2E;
typedef ATT_LAS const char* lds_cptr;
__device__ __forceinline__ int crow(int r, int hi) { return (r & 3) + 8 * (r >> 2) + 4 * hi; }
__device__ __forceinline__ void glds16(const void* gsrc, unsigned lds_dst) { unsigned keep;
    asm volatile("s_mov_b32 %0, m0\n\ts_mov_b32 m0, %2\n\ts_nop 0\n\tglobal_load_lds_dwordx4 %1, off\n\ts_mov_b32 m0, %0" : "=&s"(keep) : "v"(gsrc), "s"(lds_dst) : "memory"); }
typedef float f32x2_t __attribute__((ext_vector_type(2))); typedef __bf16 bf16x2_t __attribute__((ext_vector_type(2)));
__device__ __forceinline__ unsigned cvtpk_s(float lo, float hi) { f32x2_t v = {lo, hi}; bf16x2_t b = __builtin_convertvector(v, bf16x2_t); return __builtin_bit_cast(unsigned, b); }
#define ATT_WAIT_BAR() asm volatile("s_waitcnt vmcnt(0) lgkmcnt(0)\n\ts_barrier" ::: "memory")
#define ATT_MFMA(a, b, c) __builtin_amdgcn_mfma_f32_32x32x16_bf16((a), (b), (c), 0, 0, 0)
__device__ __forceinline__ float max3f(float a, float b, float c) { float r; asm("v_max3_f32 %0, %1, %2, %3" : "=v"(r) : "v"(a), "v"(b), "v"(c)); return r; }
__device__ __forceinline__ float max2f(float a, float b) { float r; asm("v_max_f32_e32 %0, %1, %2" : "=v"(r) : "v"(a), "v"(b)); return r; }

__device__ __forceinline__ void qkt(f32x16& p0, f32x16& p1, lds_cptr kb, const bf16x8* qr, const f32x16& z) {
#pragma unroll
    for (int d0 = 0; d0 < 4; ++d0) {
        const bf16x8 b0 = *(const ATT_LAS bf16x8*)(kb + d0 * 2048);
        const bf16x8 b1 = *(const ATT_LAS bf16x8*)(kb + d0 * 2048 + 512);
        if (d0 == 0) { p0 = ATT_MFMA(b0, qr[0], z); p1 = ATT_MFMA(b1, qr[0], z); }
        else { p0 = ATT_MFMA(b0, qr[d0], p0); p1 = ATT_MFMA(b1, qr[d0], p1); } }
}
__device__ __forceinline__ void pv(f32x16* o, int vb, bf16x8 pa0, bf16x8 pa1, bf16x8 pa2, bf16x8 pa3) {
#pragma unroll
    for (int d0 = 0; d0 < 2; ++d0) { s16x4 lo[4], hi[4];
#pragma unroll
        for (int ks = 0; ks < 4; ++ks) {
            asm volatile("ds_read_b64_tr_b16 %0,%1 offset:%c2" : "=&v"(lo[ks]) : "v"(vb), "i"(d0 * 4096 + ks * 1024) : "memory");
            asm volatile("ds_read_b64_tr_b16 %0,%1 offset:%c2" : "=&v"(hi[ks]) : "v"(vb), "i"(d0 * 4096 + ks * 1024 + 512) : "memory"); }
        asm volatile("s_waitcnt lgkmcnt(0)" ::: "memory"); __builtin_amdgcn_sched_barrier(0);
#define ATT_PK(k) (bf16x8){lo[k][0], lo[k][1], lo[k][2], lo[k][3], hi[k][0], hi[k][1], hi[k][2], hi[k][3]}
        o[d0] = ATT_MFMA(pa0, ATT_PK(0), o[d0]);
        o[d0] = ATT_MFMA(pa1, ATT_PK(1), o[d0]);
        o[d0] = ATT_MFMA(pa2, ATT_PK(2), o[d0]);
        o[d0] = ATT_MFMA(pa3, ATT_PK(3), o[d0]);
#undef ATT_PK
    }
}


#define ATT_RD128(dst, addr, off) asm volatile("ds_read_b128 %0, %1 offset:%c2" : "=&v"(dst) : "v"(addr), "i"(off) : "memory")
#define ATT_RDTR(dst, addr, off) asm volatile("ds_read_b64_tr_b16 %0, %1 offset:%c2" : "=&v"(dst) : "v"(addr), "i"(off) : "memory")
template <bool DO_QK, bool DO_PV> __device__ __forceinline__ void mseg(f32x16& p0, f32x16& p1, f32x16* o, unsigned kaddr, unsigned vaddr, const bf16x8* qr, const f32x16& cin,
                                                                     bf16x8 pa0, bf16x8 pa1, bf16x8 pa2, bf16x8 pa3) {
    bf16x8 kf[4]; s16x4 vl[4], vh[4];
    if (DO_QK) { ATT_RD128(kf[0], kaddr, 0); ATT_RD128(kf[1], kaddr, 512); ATT_RD128(kf[2], kaddr, 2048); ATT_RD128(kf[3], kaddr, 2560); }
    if (DO_PV) { ATT_RDTR(vl[0], vaddr, 0); ATT_RDTR(vh[0], vaddr, 512); ATT_RDTR(vl[1], vaddr, 1024); ATT_RDTR(vh[1], vaddr, 1536);
                 ATT_RDTR(vl[2], vaddr, 2048); ATT_RDTR(vh[2], vaddr, 2560); ATT_RDTR(vl[3], vaddr, 3072); ATT_RDTR(vh[3], vaddr, 3584); }
    if (DO_QK) {
        if (DO_PV) asm volatile("s_waitcnt lgkmcnt(8)" : "+v"(kf[0]), "+v"(kf[1]), "+v"(kf[2]), "+v"(kf[3]) :: "memory");
        else asm volatile("s_waitcnt lgkmcnt(0)" : "+v"(kf[0]), "+v"(kf[1]), "+v"(kf[2]), "+v"(kf[3]) :: "memory");
        __builtin_amdgcn_sched_barrier(0);
        p0 = ATT_MFMA(kf[0], qr[0], cin); p1 = ATT_MFMA(kf[1], qr[0], cin);
        p0 = ATT_MFMA(kf[2], qr[1], p0);  p1 = ATT_MFMA(kf[3], qr[1], p1);
        __builtin_amdgcn_sched_barrier(0);
        ATT_RD128(kf[0], kaddr, 4096); ATT_RD128(kf[1], kaddr, 4608); ATT_RD128(kf[2], kaddr, 6144); ATT_RD128(kf[3], kaddr, 6656);
        asm volatile("s_waitcnt lgkmcnt(0)" : "+v"(kf[0]), "+v"(kf[1]), "+v"(kf[2]), "+v"(kf[3]), "+v"(vl[0]), "+v"(vh[0]), "+v"(vl[1]), "+v"(vh[1]), "+v"(vl[2]), "+v"(vh[2]), "+v"(vl[3]), "+v"(vh[3]) :: "memory");
        __builtin_amdgcn_sched_barrier(0);
        p0 = ATT_MFMA(kf[0], qr[2], p0);  p1 = ATT_MFMA(kf[1], qr[2], p1);
        p0 = ATT_MFMA(kf[2], qr[3], p0);  p1 = ATT_MFMA(kf[3], qr[3], p1);
        __builtin_amdgcn_sched_barrier(0);
    }
    if (DO_PV) {
        if (!DO_QK) asm volatile("s_waitcnt lgkmcnt(0)" : "+v"(vl[0]), "+v"(vh[0]), "+v"(vl[1]), "+v"(vh[1]), "+v"(vl[2]), "+v"(vh[2]), "+v"(vl[3]), "+v"(vh[3]) :: "memory");
        __builtin_amdgcn_sched_barrier(0);
#define ATT_PK2(l, h) (bf16x8){l[0], l[1], l[2], l[3], h[0], h[1], h[2], h[3]}
        o[0] = ATT_MFMA(pa0, ATT_PK2(vl[0], vh[0]), o[0]); o[0] = ATT_MFMA(pa1, ATT_PK2(vl[1], vh[1]), o[0]);
        o[0] = ATT_MFMA(pa2, ATT_PK2(vl[2], vh[2]), o[0]); o[0] = ATT_MFMA(pa3, ATT_PK2(vl[3], vh[3]), o[0]);
        __builtin_amdgcn_sched_barrier(0);
        ATT_RDTR(vl[0], vaddr, 4096); ATT_RDTR(vh[0], vaddr, 4608); ATT_RDTR(vl[1], vaddr, 5120); ATT_RDTR(vh[1], vaddr, 5632);
        ATT_RDTR(vl[2], vaddr, 6144); ATT_RDTR(vh[2], vaddr, 6656); ATT_RDTR(vl[3], vaddr, 7168); ATT_RDTR(vh[3], vaddr, 7680);
        asm volatile("s_waitcnt lgkmcnt(0)" : "+v"(vl[0]), "+v"(vh[0]), "+v"(vl[1]), "+v"(vh[1]), "+v"(vl[2]), "+v"(vh[2]), "+v"(vl[3]), "+v"(vh[3]) :: "memory");
        __builtin_amdgcn_sched_barrier(0);
        o[1] = ATT_MFMA(pa0, ATT_PK2(vl[0], vh[0]), o[1]); o[1] = ATT_MFMA(pa1, ATT_PK2(vl[1], vh[1]), o[1]);
        o[1] = ATT_MFMA(pa2, ATT_PK2(vl[2], vh[2]), o[1]); o[1] = ATT_MFMA(pa3, ATT_PK2(vl[3], vh[3]), o[1]);
#undef ATT_PK2
    }
}

template <int MODE> __device__ __forceinline__ void attn_unit(int b, int h, int qb, int t_lo, const bf16_t* Q, const bf16_t* __restrict__ K, const bf16_t* __restrict__ V, bf16_t* O, ATT_LAS unsigned char* lds, const int wid, const float kn2, const float bmax) {
    int lane_ = pg8::lane_id(); asm volatile("" : "+v"(lane_));
    const int lane = lane_, r32 = lane & 31, hi = lane >> 5;
    const long rowbase = (long)b * SEQ; const int q0 = qb * QB;
    const bf16_t* Qw = Q + (rowbase + q0 + wid * QBLK) * DM + h * 64;
    const bf16_t *Kh = K + rowbase * DM + h * 64, *Vh = V + rowbase * DM + h * 64;
    const unsigned lds0 = (unsigned)(uintptr_t)lds;
    ATT_LAS float* wsf = (ATT_LAS float*)(lds + LDS_WS) + wid * 64;
    const bf16_t* ksrc = Kh + (long)lane * DM + wid * 8;
    const bf16_t* vsrc = Vh + (long)(16 * (wid & 3) + (lane >> 2)) * DM + (wid >> 2) * 32 + (lane & 3) * 8;
    const unsigned kdst = lds0 + LDS_K + wid * 1024, vdst = lds0 + LDS_V + wid * 1024;
#define DMA_K(t, slot) glds16(ksrc + (long)(t) * KVBLK * DM, (unsigned)__builtin_amdgcn_readfirstlane(kdst + (slot)))
#define DMA_V(t, slot) glds16(vsrc + (long)(t) * KVBLK * DM, (unsigned)__builtin_amdgcn_readfirstlane(vdst + (slot)))
    const int vb0 = (int)(lds0 + LDS_V) + ((lane >> 4) & 1) * 32 + (lane & 3) * 8 + (4 * hi + ((lane & 15) >> 2)) * 64;
    const lds_cptr kp0 = (lds_cptr)lds + LDS_K + hi * 1024 + r32 * 16;
    const int NT = 4 * (qb + 1), n = NT - t_lo;
#define TILE(i) (MODE == 0 ? (NT - 1 - (i)) : (i))
#define SLOT(i) ((unsigned)((i) & 3) * SLOTB)
#define WSKIP(i) (2 * (TILE(i) - (NT - 4)) > wid)
    DMA_K(TILE(0), SLOT(0)); DMA_V(TILE(0), SLOT(0)); if (n > 1) { DMA_K(TILE(1), SLOT(1)); DMA_V(TILE(1), SLOT(1)); } if (n > 2) { DMA_K(TILE(2), SLOT(2)); DMA_V(TILE(2), SLOT(2)); } if (n > 3) DMA_K(TILE(3), SLOT(3));
    bf16x8 qr[4];
#pragma unroll
    for (int d0 = 0; d0 < 4; ++d0) qr[d0] = *reinterpret_cast<const bf16x8*>(&Qw[(long)r32 * DM + d0 * 16 + hi * 8]);
    asm volatile("" : "+v"(qr[0]), "+v"(qr[1]), "+v"(qr[2]), "+v"(qr[3]));
    const int qrel = wid * QBLK + r32;
    float ref;
    { float qn2 = 0.f;
#pragma unroll
      for (int d0 = 0; d0 < 4; ++d0)
#pragma unroll
          for (int e = 0; e < 8; ++e) { const float v = __uint_as_float((unsigned)(unsigned short)qr[d0][e] << 16); qn2 += v * v; }
      qn2 += pg8::xor_lane<32>(qn2);
      ref = sqrtf(qn2 * kn2) * 1.02f - 64.f;
      if (MODE == 0) ref -= ((const ATT_LAS float*)(lds + LDS_C))[q0 + qrel]; else ref += bmax; }
    unsigned selm = 0u; float tb31 = 0.f;
    if (MODE == 1) {
        f32x16 g = {};
        const lds_cptr kmp = (lds_cptr)lds + LDS_KM + (r32 & 15) * 128 + hi * 16;
#pragma unroll
        for (int d0 = 0; d0 < 4; ++d0) { const bf16x8 a = *(const ATT_LAS bf16x8*)(kmp + d0 * 32); g = ATT_MFMA(a, qr[d0], g); }
        ATT_LAS float* gs = (ATT_LAS float*)(lds + LDS_OST + wid * 4096);
#pragma unroll
        for (int i = 0; i < 8; ++i) gs[r32 * 16 + crow(i, hi)] = g[i];
        asm volatile("s_waitcnt lgkmcnt(0)" ::: "memory");
        float gv[16];
#pragma unroll
        for (int i = 0; i < 4; ++i) { const f32x4 t4 = *(const ATT_LAS f32x4*)(gs + r32 * 16 + 4 * i); gv[4 * i] = t4[0]; gv[4 * i + 1] = t4[1]; gv[4 * i + 2] = t4[2]; gv[4 * i + 3] = t4[3]; }
#pragma unroll
        for (int k = 0; k < 3; ++k) { float best = -INFINITY; int bi = -1;
#pragma unroll
            for (int n = 0; n < 15; ++n) { const bool ok = (n < qb) && !((selm >> n) & 1u) && (gv[n] > best); best = ok ? gv[n] : best; bi = ok ? n : bi; }
            if (bi >= 0) selm |= 1u << bi; }
        tb31 = ((const ATT_LAS float*)(lds + LDS_TB))[256 + 127];
        asm volatile("s_waitcnt lgkmcnt(0)" ::: "memory");
    }
    float l_reg = 0.f; f32x16 o[2]; o[0] = f32x16{}; o[1] = f32x16{};
    f32x16 negm;
#pragma unroll
    for (int r = 0; r < 16; ++r) negm[r] = -ref;
    asm volatile("" : "+v"(negm));
    const float NEG = -INFINITY;
    f32x16 p0, p1; u32x4 pw0 = {}, pw1 = {}, pw2 = {}, pw3 = {};
    const int grp = ATT_LOCKSTEP ? 2 : (wid >> 2);
    asm volatile("s_waitcnt vmcnt(0) lgkmcnt(0)\n\ts_barrier" ::: "memory");
    if (grp == 1) asm volatile("s_barrier" ::: "memory");
#define ATT_ITER(j, DOQK, DOPV) do { \
 \
        int nissue = 0; \
        if (j >= 0) { if (j + 4 < n) { DMA_K(TILE(j + 4), SLOT(j + 4)); ++nissue; } if (j + 3 < n) { DMA_V(TILE(j + 3), SLOT(j + 3)); ++nissue; } } \
        { \
            f32x16 cin = negm; \
            if (MODE == 1 && DOQK && TILE(j + 1) < 4 * qb - 2) { \
                const float lb = ((selm >> (TILE(j + 1) >> 2)) & 1u) ? tb31 : NEG; \
_Pragma("unroll") \
                for (int r = 0; r < 16; ++r) cin[r] = negm[r] + lb; } \
            if (DOQK) qkt(p0, p1, kp0 + SLOT(j + 1), qr, cin); \
            if (DOPV) pv(o, vb0 + (int)SLOT(j), __builtin_bit_cast(bf16x8, pw0), __builtin_bit_cast(bf16x8, pw1), __builtin_bit_cast(bf16x8, pw2), __builtin_bit_cast(bf16x8, pw3)); \
        } \
        asm volatile("s_waitcnt lgkmcnt(0)\n\ts_barrier" ::: "memory"); \
 \
        if (DOQK) { \
        const int t = TILE(j + 1); \
        const int kbase = KVBLK * t; \
        if (MODE == 0) { \
            const ATT_LAS float* cl = (const ATT_LAS float*)(lds + LDS_C) + kbase + 4 * hi; \
_Pragma("unroll") \
            for (int g4 = 0; g4 < 4; ++g4) { const f32x4 c0 = *(const ATT_LAS f32x4*)(cl + 8 * g4); \
_Pragma("unroll") \
                for (int e = 0; e < 4; ++e) p0[4 * g4 + e] -= c0[e]; } \
_Pragma("unroll") \
            for (int g4 = 0; g4 < 4; ++g4) { const f32x4 c1 = *(const ATT_LAS f32x4*)(cl + 8 * g4 + 32); \
_Pragma("unroll") \
                for (int e = 0; e < 4; ++e) p1[4 * g4 + e] -= c1[e]; } \
            if (t >= NT - 4) { const int kb = 64 * (t - (NT - 4)) + 4 * hi; \
_Pragma("unroll") \
                for (int r = 0; r < 16; ++r) { const int kv = kb + (r & 3) + 8 * (r >> 2); if (kv > qrel) p0[r] = NEG; if (kv + 32 > qrel) p1[r] = NEG; } } \
        } else { \
            const int nb = t >> 2; \
            if (t >= 4 * qb - 2) { \
 \
                const bool sel = (nb == qb) || ((selm >> nb) & 1u); \
                const int relb = q0 + qrel - kbase - 4 * hi; \
                const ATT_LAS float* pbp = (const ATT_LAS float*)(lds + LDS_TB) + (sel ? relb + 197 : 640); \
_Pragma("unroll") \
                for (int r = 0; r < 16; ++r) { const int off = (r & 3) + 8 * (r >> 2); p0[r] += pbp[59 - off]; p1[r] += pbp[27 - off]; } \
            } \
        } \
        float sacc = 0.f; \
_Pragma("unroll") \
        for (int r = 0; r < 16; ++r) { p0[r] = __builtin_amdgcn_exp2f(p0[r]); p1[r] = __builtin_amdgcn_exp2f(p1[r]); sacc += p0[r] + p1[r]; } \
        l_reg += sacc; \
        pw0 = (u32x4){cvtpk_s(p0[0], p0[1]), cvtpk_s(p0[2], p0[3]), cvtpk_s(p0[4], p0[5]), cvtpk_s(p0[6], p0[7])}; \
        pw1 = (u32x4){cvtpk_s(p0[8], p0[9]), cvtpk_s(p0[10], p0[11]), cvtpk_s(p0[12], p0[13]), cvtpk_s(p0[14], p0[15])}; \
        pw2 = (u32x4){cvtpk_s(p1[0], p1[1]), cvtpk_s(p1[2], p1[3]), cvtpk_s(p1[4], p1[5]), cvtpk_s(p1[6], p1[7])}; \
        pw3 = (u32x4){cvtpk_s(p1[8], p1[9]), cvtpk_s(p1[10], p1[11]), cvtpk_s(p1[12], p1[13]), cvtpk_s(p1[14], p1[15])}; \
        } \
 \
        if (nissue == 2) asm volatile("s_waitcnt vmcnt(2) lgkmcnt(0)\n\ts_barrier" ::: "memory"); \
        else if (nissue == 1) asm volatile("s_waitcnt vmcnt(1) lgkmcnt(0)\n\ts_barrier" ::: "memory"); \
        else asm volatile("s_waitcnt vmcnt(0) lgkmcnt(0)\n\ts_barrier" ::: "memory"); \
    } while (0)
    ATT_ITER(-1, true, false);
#pragma unroll 1
    for (int j = 0; j < n - 1; ++j) ATT_ITER(j, true, true);
    ATT_ITER(n - 1, false, true);
#undef ATT_ITER
    if (grp == 0) asm volatile("s_barrier" ::: "memory");
    { const int lane2 = pg8::lane_id(), r32b = lane2 & 31, hib = lane2 >> 5;
      ATT_LAS float* wsf2 = (ATT_LAS float*)(lds + LDS_WS) + wid * 64;
      { auto rr = __builtin_amdgcn_permlane32_swap(__float_as_uint(l_reg), __float_as_uint(l_reg), false, false); l_reg = __uint_as_float(rr[0]) + __uint_as_float(rr[1]); }
      if (hib == 0) wsf2[32 + r32b] = l_reg;
      asm volatile("s_waitcnt lgkmcnt(0)" ::: "memory");
      float rli[16];
#pragma unroll
      for (int r = 0; r < 16; ++r) rli[r] = __builtin_amdgcn_rcpf(wsf2[32 + crow(r, hib)]);
      bf16_t* Ow = O + ((long)b * SEQ + qb * QB + wid * QBLK) * DM + h * 64;
      ATT_LAS bf16_t* stg = (ATT_LAS bf16_t*)(lds + LDS_OST) + wid * 2048;
#pragma unroll
      for (int r = 0; r < 16; ++r) { const int orow = crow(r, hib);
#pragma unroll
          for (int d0 = 0; d0 < 2; ++d0) stg[orow * 64 + d0 * 32 + r32b] = (bf16_t)(cvtpk_s(o[d0][r] * rli[r], 0.f) & 0xffffu); }
      asm volatile("s_waitcnt lgkmcnt(0)" ::: "memory");
#pragma unroll
      for (int i = 0; i < 4; ++i) { const int row = i * 8 + (lane2 >> 3), ch = lane2 & 7; const u32x4 v = *(const ATT_LAS u32x4*)(stg + row * 64 + ch * 8); *(u32x4*)(Ow + (long)row * DM + ch * 8) = v; } }
    asm volatile("s_waitcnt lgkmcnt(0)" ::: "memory");
#undef DMA_K
#undef DMA_V
#undef TILE
#undef SLOT
#undef WSKIP
}
}
#define LAS __attribute__((address_space(3)))
#define SSQ(s) (ssq + (size_t)((s) & 3) * M * 16)
#define XB_TMO      128
#define XB_XCNT(j)  (256  + 64 * (j))
#define XB_XSUB(j)  (1280 + 64 * (j))
#define XB_XGEN(j)  (2304 + 64 * (j))
#define XB_TOP      3328
#define XB_TOPGEN   3392
#define XCD_BAR_WORDS 3456
#define XB_SPIN_CAP (1u << 18)

__device__ __forceinline__ unsigned xb_ld(unsigned* p)              { return __hip_atomic_load(p, __ATOMIC_RELAXED, __HIP_MEMORY_SCOPE_AGENT); }
__device__ __forceinline__ unsigned xb_add(unsigned* p, unsigned v) { return __hip_atomic_fetch_add(p, v, __ATOMIC_RELAXED, __HIP_MEMORY_SCOPE_AGENT); }
__device__ __forceinline__ unsigned xb_xcc_id() { return (unsigned)__builtin_amdgcn_s_getreg((3 << 11) | 20) & 0xFu; }
#define XB_SPIN(cond, bar) do { unsigned _sp = 0; while (cond) { __builtin_amdgcn_s_sleep(1); \
    if ((++_sp & 255u) == 0u) { if (xb_ld(&(bar)[XB_TMO])) break; if (_sp > XB_SPIN_CAP) { atomicAdd(&(bar)[XB_TMO], 1u); break; } } } } while (0)

struct XcdBarrier {
    unsigned* bar; unsigned x;
    volatile LAS unsigned* st;
};

__device__ __forceinline__ XcdBarrier xcd_barrier_post(unsigned* bar, volatile LAS unsigned* st, const bool is_t0) {
    XcdBarrier b; b.bar = bar; b.x = xb_xcc_id(); b.st = st;
    if (is_t0) (void)xb_add(&bar[XB_XCNT(b.x)], 1u);
    return b;
}
__device__ __forceinline__ void xcd_barrier_complete(unsigned* bar, unsigned x, unsigned& nloc, unsigned& nx) {
    const unsigned G = gridDim.x * gridDim.y * gridDim.z;
    unsigned sum, cnt, mine, sp = 0u;
    for (;;) {
        sum = 0u; cnt = 0u; mine = 0u;
#pragma unroll
        for (unsigned j = 0; j < 16; ++j) { const unsigned c = xb_ld(&bar[XB_XCNT(j)]); sum += c; cnt += (c > 0u) ? 1u : 0u; mine = (j == x) ? c : mine; }
        if (sum == G) break;
        __builtin_amdgcn_s_sleep(1);
        if ((++sp & 255u) == 0u) { if (xb_ld(&bar[XB_TMO])) break; if (sp > XB_SPIN_CAP) { atomicAdd(&bar[XB_TMO], 1u); break; } }
    }
    nloc = mine > 0u ? mine : 1u; nx = cnt > 0u ? cnt : 1u;
}

__device__ __forceinline__ void xcd_barrier(const XcdBarrier& b, const bool is_t0) {
    asm volatile("s_waitcnt vmcnt(0)" ::: "memory");
    __syncthreads();
    if (is_t0) {
        unsigned* bar = b.bar;
        __builtin_amdgcn_s_waitcnt(0);
        unsigned nloc = b.st[0], nx = b.st[1];
        if (nloc == 0u) { xcd_barrier_complete(bar, b.x, nloc, nx); b.st[0] = nloc; b.st[1] = nx; }
        const unsigned old = xb_add(&bar[XB_XSUB(b.x)], 1u);
        const unsigned gen = old / nloc;
        if (old + 1u == (gen + 1u) * nloc) {
            __builtin_amdgcn_fence(__ATOMIC_RELEASE, "agent");
            asm volatile("s_waitcnt vmcnt(0)" ::: "memory");
            const unsigned og = xb_add(&bar[XB_TOP], 1u);
            const unsigned tg = og / nx;
            if (og + 1u == (tg + 1u) * nx) xb_add(&bar[XB_TOPGEN], 1u);
            else XB_SPIN(xb_ld(&bar[XB_TOPGEN]) == tg, bar);
            __builtin_amdgcn_fence(__ATOMIC_ACQUIRE, "agent");
            xb_add(&bar[XB_XGEN(b.x)], 1u);
            asm volatile("s_waitcnt vmcnt(0)" ::: "memory");
        } else {
            XB_SPIN(xb_ld(&bar[XB_XGEN(b.x)]) == gen, bar);
            __builtin_amdgcn_fence(__ATOMIC_ACQUIRE, "agent");
            asm volatile("s_waitcnt vmcnt(0)" ::: "memory");
        }
    }
    __syncthreads();
}
typedef unsigned short bf16;
typedef unsigned v4u __attribute__((ext_vector_type(4)));
typedef float f32x4 __attribute__((ext_vector_type(4)));
typedef short bf16x8 __attribute__((ext_vector_type(8)));
#ifndef PROBE_DUP_FOX
#define PROBE_DUP_FOX 0
#endif
#ifndef PROBE_DUP_MOBA
#define PROBE_DUP_MOBA 0
#endif
#ifndef PROBE_DUP_SYNC
#define PROBE_DUP_SYNC 0
#endif
#define GRID_SYNC() do { XcdBarrier xb_; xb_.bar = (unsigned*)args.ws; xb_.x = xb_xcc_id(); xb_.st = (volatile LAS unsigned*)(lds + 131072) + 8; const bool t0_ = (wid_s == 0) && (pg8::lane_id() == 0); xcd_barrier(xb_, t0_); if (PROBE_DUP_SYNC) xcd_barrier(xb_, t0_); } while (0)
#ifndef SINGLE_ALIGN
#define SINGLE_ALIGN true
#endif
constexpr int NWAVES = 8;
constexpr int M = 16384, D = 1024, NH = 16, SEQ = 4096, FF = 2816, PD = 256, DEPTH = 4;
constexpr int LDS_BYTES = 147456;
constexpr size_t MiB = 1u << 20;
constexpr size_t WS_SSQ = 1 * MiB;
constexpr size_t WS_LOGF = 2 * MiB;
constexpr size_t WS_W = 4 * MiB, W_LAYER = 28 * MiB;
constexpr size_t WO_QKV = 0, WO_O = 3145728, WO_FI = 4194304, WO_FO = 9961472, WO_G = 12845056, WO_U = 13893632, WO_F = 14155776;
constexpr size_t WS_HB = 116 * MiB;
constexpr size_t WS_QO = 148 * MiB, WS_K = 180 * MiB, WS_V = 212 * MiB;
constexpr size_t WS_UP = 244 * MiB;
constexpr size_t WS_PB = 276 * MiB;
constexpr size_t WS_HB2 = 308 * MiB;
constexpr size_t WS_SSQ16 = 340 * MiB;
constexpr size_t WS_END = 344 * MiB;

__device__ __forceinline__ unsigned pk2(float lo, float hi) { return pg8::cvt_pk_bf16(lo, hi); }
__device__ __forceinline__ float wave_sum(float v) {
    v += pg8::xor_lane<1>(v); v += pg8::xor_lane<2>(v); v += pg8::xor_lane<4>(v); v += pg8::xor_lane<8>(v); v += pg8::xor_lane<16>(v); v += pg8::xor_lane<32>(v);
    return v;
}
struct TItem { const float* W; const float* gk; bf16* WT; int ldw, K, k0, n0, dst; };
__device__ __forceinline__ void titem_load(const TItem& T, f32x4 (&v)[8], int lane) {
    const int c4 = (lane & 7) * 4;
#pragma unroll
    for (int i = 0; i < 8; ++i) v[i] = *(const f32x4*)(T.W + (size_t)(T.k0 + 8 * i + (lane >> 3)) * T.ldw + T.n0 + c4);
}
__device__ __forceinline__ void titem_store(const TItem& T, f32x4 (&v)[8], LAS float* scr, int lane) {
    const int c4 = (lane & 7) * 4;
#pragma unroll
    for (int i = 0; i < 8; ++i) { if (T.gk != nullptr) v[i] = v[i] * T.gk[T.k0 + 8 * i + (lane >> 3)];
        LAS float* d = scr + (8 * i + (lane >> 3)) * 33 + c4; d[0] = v[i][0]; d[1] = v[i][1]; d[2] = v[i][2]; d[3] = v[i][3]; }
    asm volatile("s_waitcnt lgkmcnt(0)" ::: "memory");
    const int c = lane & 7;
#pragma unroll
    for (int j = 0; j < 4; ++j) { const int n = (lane >> 3) + 8 * j; const LAS float* s = scr + (8 * c) * 33 + n;
        v4u o; if (T.gk != nullptr) { o.x = pg8::pk_f16(s[0 * 33], s[1 * 33]); o.y = pg8::pk_f16(s[2 * 33], s[3 * 33]); o.z = pg8::pk_f16(s[4 * 33], s[5 * 33]); o.w = pg8::pk_f16(s[6 * 33], s[7 * 33]); }
        else { o.x = pk2(s[0 * 33], s[1 * 33]); o.y = pk2(s[2 * 33], s[3 * 33]); o.z = pk2(s[4 * 33], s[5 * 33]); o.w = pk2(s[6 * 33], s[7 * 33]); }
        *(v4u*)(T.WT + (size_t)(T.dst + n) * T.K + T.k0 + 8 * c) = o; }
    asm volatile("s_waitcnt lgkmcnt(0)" ::: "memory");
}

struct Args { const float* in[16]; float* out; unsigned char* ws; };

struct UpOrder { int c;
    __device__ __forceinline__ bool next(int i, pg8::Unit& u) const { if (c < 128 || i >= 2) return false; const int idx = (c - 128) * 2 + i; u.pm = idx >> 2; u.pn = idx & 3; return true; }
    __device__ __forceinline__ void a_ready(const pg8::Unit&) const {}
    __device__ __forceinline__ void done(const pg8::Unit&) const {}
};
template <int li> __device__ __forceinline__ void layer_fwd(const Args& args, LAS unsigned char* lds, const int wid_s) {
#define HCUR ((li & 1) ? HB : HB2)
#define HOTH ((li & 1) ? HB2 : HB)
        const int j = li >> 1; const bool fox = !(li & 1);
        {
        int lane_ = pg8::lane_id(); asm volatile("" : "+v"(lane_)); const int lane = lane_, wave = wid_s, tid = wave * 64 + lane;
        int bx_ = blockIdx.x; asm volatile("" : "+s"(bx_)); const int bx = bx_, G = gridDim.x;
        const int vcu = (G % 8 == 0) ? (bx % 8) * (G / 8) + bx / 8 : bx; const int gw = vcu * NWAVES + wave, NGW = G * NWAVES;
        (void)tid; (void)lane; (void)wave; (void)bx; (void)vcu; (void)gw; (void)NGW;
        int zs = 0; asm volatile("" : "+s"(zs));
        unsigned char* ws = args.ws + zs;
#define INP(k) (args.in[(k) + zs])
        float* out = args.out + zs;
        float* ssq = (float*)(ws + WS_SSQ16); float* logf_buf = (float*)(ws + WS_LOGF);
        bf16* HB = (bf16*)(ws + WS_HB); bf16* HB2 = (bf16*)(ws + WS_HB2); bf16* QO = (bf16*)(ws + WS_QO); bf16* KB = (bf16*)(ws + WS_K); bf16* VB = (bf16*)(ws + WS_V);
        bf16* ACT = (bf16*)(ws + WS_QO); bf16* UP = (bf16*)(ws + WS_UP); bf16* PB = (bf16*)(ws + WS_PB);
        (void)out; (void)ssq; (void)logf_buf; (void)HB; (void)HB2; (void)QO; (void)KB; (void)VB; (void)ACT; (void)UP; (void)PB;
        bf16* Wl = (bf16*)(ws + WS_W + (size_t)li * W_LAYER); const float* fox_b_f = INP(4);
            pg8::Gemm g{HCUR, Wl + WO_QKV, M, 3 * D, D}; pg8::StaticOrder S; S.init(M, 3 * D, G, bx);
            unsigned* nrm = (unsigned*)ws + 8192 + li * 2304;
            if (lane == 0) ((LAS int*)(lds + pg8::RSC_OFF))[wave * pg8::RSC_STRIDE] = 0;
            pg8::EpiQKV E{QO, (size_t)(WS_K - WS_QO) / 2, SSQ(3 * li), att::C2, fox ? nrm : nullptr, nrm + 2048, lds};
            pg8::gemm_phase<pg8::EpiQKV, pg8::StaticOrder, true, true, true>(lds, g, S, E, wid_s);
            if (fox) {
                const int fr = lane & 15, fq = lane >> 4; const float* ssq_in = SSQ(3 * li); const float* bfp = fox_b_f + j * 16;
                for (int task = gw; task < M / 16; task += NGW) {
                    const int row0 = task * 16; f32x4 acc = {0.f, 0.f, 0.f, 0.f};
                    const bf16* ap = HCUR + (size_t)(row0 + fr) * D + 8 * fq; const bf16* bp = Wl + WO_F + fr * 1024 + 8 * fq;
#pragma unroll 16
                    for (int kk = 0; kk < 32; ++kk) { const bf16x8 xw = *(const bf16x8*)(bp + 32 * kk), ya = *(const bf16x8*)(ap + 32 * kk);
                        acc = pg8::mma16<true>(xw, ya, acc); }
                    const int token = row0 + fr; const float rs = pg8::rstd_row(ssq_in, token); const int bb = token >> 12, s = token & 4095;
#pragma unroll
                    for (int e = 0; e < 4; ++e) { const int hh = 4 * fq + e; const float f = acc[e] * rs + bfp[hh];
                        const float lg = fminf(f, 0.f) - log1pf(expf(-fabsf(f))); logf_buf[(size_t)(bb * 16 + hh) * SEQ + s] = lg; }
                }
            }
        }
        GRID_SYNC();
        {
        int lane_ = pg8::lane_id(); asm volatile("" : "+v"(lane_)); const int lane = lane_, wave = wid_s, tid = wave * 64 + lane;
        int bx_ = blockIdx.x; asm volatile("" : "+s"(bx_)); const int bx = bx_, G = gridDim.x;
        const int vcu = (G % 8 == 0) ? (bx % 8) * (G / 8) + bx / 8 : bx; const int gw = vcu * NWAVES + wave, NGW = G * NWAVES;
        (void)tid; (void)lane; (void)wave; (void)bx; (void)vcu; (void)gw; (void)NGW;
        int zs = 0; asm volatile("" : "+s"(zs));
        unsigned char* ws = args.ws + zs;
#define INP(k) (args.in[(k) + zs])
        float* out = args.out + zs;
        float* ssq = (float*)(ws + WS_SSQ16); float* logf_buf = (float*)(ws + WS_LOGF);
        bf16* HB = (bf16*)(ws + WS_HB); bf16* HB2 = (bf16*)(ws + WS_HB2); bf16* QO = (bf16*)(ws + WS_QO); bf16* KB = (bf16*)(ws + WS_K); bf16* VB = (bf16*)(ws + WS_V);
        bf16* ACT = (bf16*)(ws + WS_QO); bf16* UP = (bf16*)(ws + WS_UP); bf16* PB = (bf16*)(ws + WS_PB);
        (void)out; (void)ssq; (void)logf_buf; (void)HB; (void)HB2; (void)QO; (void)KB; (void)VB; (void)ACT; (void)UP; (void)PB;
        const float* rel_tab = INP(8);
            const int bh = vcu >> 2, sidx = vcu & 3, b = bh >> 4, h = bh & 15;
            float kn2; { const unsigned* nkp = (const unsigned*)ws + 8192 + li * 2304 + 2048 + bh * 2; kn2 = __uint_as_float(nkp[0]) + __uint_as_float(nkp[1]); }
            if (fox) {
                unsigned* qctr = (unsigned*)ws + 24576 + j;
                LAS unsigned* uq = (LAS unsigned*)(lds + att::LDS_SC + 64);
                const float bmax = 0.f;
#pragma unroll 1
                for (;;) {
                    int zl = 0; asm volatile("" : "+v"(zl));
                    if ((wid_s == 0) && (pg8::lane_id() == 0)) uq[zl] = atomicAdd(qctr, 1u);
                    __syncthreads();
                    const unsigned u = (unsigned)__builtin_amdgcn_readfirstlane((int)uq[zl]);
                    if (u >= 1024u) break;
                    const int qb = 15 - (int)(u >> 6), bh = (int)(u & 63u), b = bh >> 4, h = bh & 15;
                    const int lnl = pg8::lane_id(); const int tdl = wid_s * 64 + lnl;
                    const int L = 256 * (qb + 1);
                    float v[8];
                    if (8 * tdl < L) { const float* lf = logf_buf + (size_t)bh * SEQ + 8 * tdl; const f32x4 a = *(const f32x4*)lf, c = *(const f32x4*)(lf + 4);
                        v[0] = a[0]; v[1] = v[0] + a[1]; v[2] = v[1] + a[2]; v[3] = v[2] + a[3]; v[4] = v[3] + c[0]; v[5] = v[4] + c[1]; v[6] = v[5] + c[2]; v[7] = v[6] + c[3]; }
                    else {
#pragma unroll
                        for (int e = 0; e < 8; ++e) v[e] = 0.f; }
                    float incl = v[7];
#pragma unroll
                    for (int o = 1; o < 64; o <<= 1) { const float t = __int_as_float(__builtin_amdgcn_ds_bpermute(((lnl - o) & 63) << 2, __float_as_int(incl))); if (lnl >= o) incl += t; }
                    LAS float* wsum = (LAS float*)(lds + att::LDS_SC);
                    if (lnl == 63) wsum[tdl >> 6] = incl;
                    __syncthreads();
                    float basev = incl - v[7];
                    { int wv = wave; asm volatile("" : "+s"(wv));
#pragma unroll
                      for (int w = 0; w < 7; ++w) basev += (w < wv) ? wsum[w] : 0.f; }
                    LAS float* cl = (LAS float*)(lds + att::LDS_C) + 8 * tdl;
#pragma unroll
                    for (int e = 0; e < 8; ++e) cl[e] = (basev + v[e]) * att::LOG2E;
                    __syncthreads();
                    float kn2; { const unsigned* nkp = (const unsigned*)ws + 8192 + li * 2304 + 2048 + bh * 2; kn2 = __uint_as_float(nkp[0]) + __uint_as_float(nkp[1]); }
                    int t_lo = 0;
                    { const unsigned* nrm = (const unsigned*)ws + 8192 + li * 2304; const unsigned* nqp = nrm + (bh * 16 + qb) * 2;
                      const float qn2 = __uint_as_float(nqp[0]) + __uint_as_float(nqp[1]);
                      const float B2 = sqrtf(qn2 * kn2) * 1.02f; const LAS float* cl2 = (const LAS float*)(lds + att::LDS_C);
                      const bool skip = (lnl < 4 * qb) && (2.f * B2 + (cl2[256 * qb] - cl2[64 * lnl + 63]) <= -152.f);
                      const unsigned long long msk = __ballot(skip); t_lo = msk ? 64 - __builtin_clzll(msk) : 0; t_lo = __builtin_amdgcn_readfirstlane(t_lo); }
                    att::attn_unit<0>(b, h, qb, t_lo, QO, KB, VB, QO, lds, wid_s, kn2, bmax);
                }
            } else {
                const bf16* Kh = KB + (size_t)b * SEQ * D + h * 64; const int ks = tid >> 3, ch = tid & 7;
                LAS float* red = (LAS float*)(lds + att::LDS_OST);
#pragma unroll 5
                for (int n = 0; n < 15; ++n) { float a8[8] = {0.f, 0.f, 0.f, 0.f, 0.f, 0.f, 0.f, 0.f};
#pragma unroll
                    for (int i = 0; i < 4; ++i) { const v4u w = *(const v4u*)(Kh + (size_t)(256 * n + ks + 64 * i) * D + ch * 8);
                        a8[0] += __uint_as_float(w.x << 16); a8[1] += __uint_as_float(w.x & 0xffff0000u); a8[2] += __uint_as_float(w.y << 16); a8[3] += __uint_as_float(w.y & 0xffff0000u);
                        a8[4] += __uint_as_float(w.z << 16); a8[5] += __uint_as_float(w.z & 0xffff0000u); a8[6] += __uint_as_float(w.w << 16); a8[7] += __uint_as_float(w.w & 0xffff0000u); }
#pragma unroll
                    for (int e = 0; e < 8; ++e) { a8[e] += pg8::xor_lane<8>(a8[e]); a8[e] += pg8::xor_lane<16>(a8[e]); a8[e] += pg8::xor_lane<32>(a8[e]); }
                    if (lane < 8) {
#pragma unroll
                        for (int e = 0; e < 8; ++e) red[(n * 8 + wave) * 64 + ch * 8 + e] = a8[e]; } }
                for (int idx = tid; idx < 704; idx += NWAVES * 64) { const int rel = idx - 256; float val = -INFINITY;
                    if (idx < 640 && rel >= 0) { const int n = rel < 127 ? rel : 127; int bucket;
                        if (n < 16) bucket = n; else { const float nf = (float)n; int large = 16 + (int)(logf(nf / 16.0f) / 2.0794415416798357f * 16.0f); bucket = large < 31 ? large : 31; }
                        val = rel_tab[bucket * 16 + h] * att::LOG2E; }
                    ((LAS float*)(lds + att::LDS_TB))[idx] = val; }
                __syncthreads();
                for (int idx = tid; idx < 1024; idx += NWAVES * 64) { const int n = idx >> 6, d = idx & 63; float s = 0.f;
                    if (n < 15) {
#pragma unroll
                        for (int w = 0; w < 8; ++w) s += red[(n * 8 + w) * 64 + d]; }
                    ((LAS bf16*)(lds + att::LDS_KM))[idx] = (bf16)(pk2(s * (1.0f / 256.0f), 0.f) & 0xffffu); }
                __syncthreads();
                float bmax = -INFINITY; for (int bk = 0; bk < 32; ++bk) bmax = fmaxf(bmax, rel_tab[bk * 16 + h] * att::LOG2E);
#pragma unroll 1
                for (int rep = 1 - PROBE_DUP_MOBA; rep < 2; ++rep)
#pragma unroll 1
                for (int i = 0; i < 4; ++i) { const int qb = (i == 0) ? sidx : (i == 1) ? 7 - sidx : (i == 2) ? 8 + sidx : 15 - sidx;
                    att::attn_unit<1>(b, h, qb, 0, QO, KB, VB, (rep == 0) ? UP : QO, lds, wid_s, kn2, bmax); }
            }
            asm volatile("s_waitcnt vmcnt(0)" ::: "memory");
        }
        GRID_SYNC();
        {
        int lane_ = pg8::lane_id(); asm volatile("" : "+v"(lane_)); const int lane = lane_, wave = wid_s, tid = wave * 64 + lane;
        int bx_ = blockIdx.x; asm volatile("" : "+s"(bx_)); const int bx = bx_, G = gridDim.x;
        const int vcu = (G % 8 == 0) ? (bx % 8) * (G / 8) + bx / 8 : bx; const int gw = vcu * NWAVES + wave, NGW = G * NWAVES;
        (void)tid; (void)lane; (void)wave; (void)bx; (void)vcu; (void)gw; (void)NGW;
        int zs = 0; asm volatile("" : "+s"(zs));
        unsigned char* ws = args.ws + zs;
#define INP(k) (args.in[(k) + zs])
        float* out = args.out + zs;
        float* ssq = (float*)(ws + WS_SSQ16); float* logf_buf = (float*)(ws + WS_LOGF);
        bf16* HB = (bf16*)(ws + WS_HB); bf16* HB2 = (bf16*)(ws + WS_HB2); bf16* QO = (bf16*)(ws + WS_QO); bf16* KB = (bf16*)(ws + WS_K); bf16* VB = (bf16*)(ws + WS_V);
        bf16* ACT = (bf16*)(ws + WS_QO); bf16* UP = (bf16*)(ws + WS_UP); bf16* PB = (bf16*)(ws + WS_PB);
        (void)out; (void)ssq; (void)logf_buf; (void)HB; (void)HB2; (void)QO; (void)KB; (void)VB; (void)ACT; (void)UP; (void)PB;
        bf16* Wl = (bf16*)(ws + WS_W + (size_t)li * W_LAYER); const float* x = INP(0); const float* ffn_g = INP(9);
            { pg8::Gemm g{QO, Wl + WO_O, M, D, D}; pg8::StaticOrder S; S.init(M, D, G, bx);
              pg8::EpiResid<0, false, false> E{HCUR, HOTH, SSQ(3 * li + 1), nullptr, nullptr}; (void)ffn_g; (void)x;
              pg8::gemm_phase<pg8::EpiResid<0, false, false>, pg8::StaticOrder, SINGLE_ALIGN, true>(lds, g, S, E, wid_s); }
        }
        GRID_SYNC();
        {
        int lane_ = pg8::lane_id(); asm volatile("" : "+v"(lane_)); const int lane = lane_, wave = wid_s, tid = wave * 64 + lane;
        int bx_ = blockIdx.x; asm volatile("" : "+s"(bx_)); const int bx = bx_, G = gridDim.x;
        const int vcu = (G % 8 == 0) ? (bx % 8) * (G / 8) + bx / 8 : bx; const int gw = vcu * NWAVES + wave, NGW = G * NWAVES;
        (void)tid; (void)lane; (void)wave; (void)bx; (void)vcu; (void)gw; (void)NGW;
        int zs = 0; asm volatile("" : "+s"(zs));
        unsigned char* ws = args.ws + zs;
#define INP(k) (args.in[(k) + zs])
        float* out = args.out + zs;
        float* ssq = (float*)(ws + WS_SSQ16); float* logf_buf = (float*)(ws + WS_LOGF);
        bf16* HB = (bf16*)(ws + WS_HB); bf16* HB2 = (bf16*)(ws + WS_HB2); bf16* QO = (bf16*)(ws + WS_QO); bf16* KB = (bf16*)(ws + WS_K); bf16* VB = (bf16*)(ws + WS_V);
        bf16* ACT = (bf16*)(ws + WS_QO); bf16* UP = (bf16*)(ws + WS_UP); bf16* PB = (bf16*)(ws + WS_PB);
        (void)out; (void)ssq; (void)logf_buf; (void)HB; (void)HB2; (void)QO; (void)KB; (void)VB; (void)ACT; (void)UP; (void)PB;
        bf16* Wl = (bf16*)(ws + WS_W + (size_t)li * W_LAYER);
            pg8::Gemm g{HOTH, Wl + WO_FI, M, 2 * FF, D}; pg8::StaticOrder S; S.init(M, 2 * FF, G, bx);
            if (lane == 0) ((LAS int*)(lds + pg8::RSC_OFF))[wave * pg8::RSC_STRIDE] = 0;
            pg8::EpiSwiGLU E{ACT, SSQ(3 * li + 1), lds};
            pg8::gemm_phase<pg8::EpiSwiGLU, pg8::StaticOrder, true, true, true>(lds, g, S, E, wid_s);
            { pg8::Gemm g2{PB + (size_t)li * M * PD, Wl + WO_U, M, D, PD}; UpOrder S2{bx}; pg8::EpiStoreBf16 E2{UP};
              pg8::gemm_phase<pg8::EpiStoreBf16, UpOrder, true, true>(lds, g2, S2, E2, wid_s); }
        }
        GRID_SYNC();
        {
        int lane_ = pg8::lane_id(); asm volatile("" : "+v"(lane_)); const int lane = lane_, wave = wid_s, tid = wave * 64 + lane;
        int bx_ = blockIdx.x; asm volatile("" : "+s"(bx_)); const int bx = bx_, G = gridDim.x;
        const int vcu = (G % 8 == 0) ? (bx % 8) * (G / 8) + bx / 8 : bx; const int gw = vcu * NWAVES + wave, NGW = G * NWAVES;
        (void)tid; (void)lane; (void)wave; (void)bx; (void)vcu; (void)gw; (void)NGW;
        int zs = 0; asm volatile("" : "+s"(zs));
        unsigned char* ws = args.ws + zs;
#define INP(k) (args.in[(k) + zs])
        float* out = args.out + zs;
        float* ssq = (float*)(ws + WS_SSQ16); float* logf_buf = (float*)(ws + WS_LOGF);
        bf16* HB = (bf16*)(ws + WS_HB); bf16* HB2 = (bf16*)(ws + WS_HB2); bf16* QO = (bf16*)(ws + WS_QO); bf16* KB = (bf16*)(ws + WS_K); bf16* VB = (bf16*)(ws + WS_V);
        bf16* ACT = (bf16*)(ws + WS_QO); bf16* UP = (bf16*)(ws + WS_UP); bf16* PB = (bf16*)(ws + WS_PB);
        (void)out; (void)ssq; (void)logf_buf; (void)HB; (void)HB2; (void)QO; (void)KB; (void)VB; (void)ACT; (void)UP; (void)PB;
        bf16* Wl = (bf16*)(ws + WS_W + (size_t)li * W_LAYER); const float* ple_g = INP(12);
            pg8::Gemm g{ACT, Wl + WO_FO, M, D, FF}; pg8::StaticOrder S; S.init(M, D, G, bx);
            pg8::EpiResid<0, false, false> E{HOTH, HCUR, SSQ(3 * li + 2), nullptr, nullptr}; (void)ple_g;
            pg8::gemm_phase<pg8::EpiResid<0, false, false>, pg8::StaticOrder, SINGLE_ALIGN, true>(lds, g, S, E, wid_s);
        }
        GRID_SYNC();
        {
        int lane_ = pg8::lane_id(); asm volatile("" : "+v"(lane_)); const int lane = lane_, wave = wid_s, tid = wave * 64 + lane;
        int bx_ = blockIdx.x; asm volatile("" : "+s"(bx_)); const int bx = bx_, G = gridDim.x;
        const int vcu = (G % 8 == 0) ? (bx % 8) * (G / 8) + bx / 8 : bx; const int gw = vcu * NWAVES + wave, NGW = G * NWAVES;
        (void)tid; (void)lane; (void)wave; (void)bx; (void)vcu; (void)gw; (void)NGW;
        int zs = 0; asm volatile("" : "+s"(zs));
        unsigned char* ws = args.ws + zs;
#define INP(k) (args.in[(k) + zs])
        float* out = args.out + zs;
        float* ssq = (float*)(ws + WS_SSQ16); float* logf_buf = (float*)(ws + WS_LOGF);
        bf16* HB = (bf16*)(ws + WS_HB); bf16* HB2 = (bf16*)(ws + WS_HB2); bf16* QO = (bf16*)(ws + WS_QO); bf16* KB = (bf16*)(ws + WS_K); bf16* VB = (bf16*)(ws + WS_V);
        bf16* ACT = (bf16*)(ws + WS_QO); bf16* UP = (bf16*)(ws + WS_UP); bf16* PB = (bf16*)(ws + WS_PB);
        (void)out; (void)ssq; (void)logf_buf; (void)HB; (void)HB2; (void)QO; (void)KB; (void)VB; (void)ACT; (void)UP; (void)PB;
        bf16* Wl = (bf16*)(ws + WS_W + (size_t)li * W_LAYER); const float* attn_g = INP(2); const float* fin_g = INP(15);
            pg8::Gemm g{HCUR, Wl + WO_G, M, D, D}; pg8::StaticOrder S; S.init(M, D, G, bx);
            (void)attn_g; (void)fin_g;
            pg8::EpiResid<1, false, false> E{HCUR, HOTH, SSQ(3 * li + 3), SSQ(3 * li + 2), UP}; (void)out;
            pg8::gemm_phase<pg8::EpiResid<1, false, false>, pg8::StaticOrder, SINGLE_ALIGN, true, true>(lds, g, S, E, wid_s);
        }
        GRID_SYNC();
}

__global__ void __launch_bounds__(NWAVES * 64, 2) fwd_megakernel(Args args) {
    extern __shared__ __attribute__((aligned(16))) unsigned char lds_raw[];
    LAS unsigned char* lds = (LAS unsigned char*)lds_raw;
    cg::grid_group grid = cg::this_grid();
    const int wid_s = __builtin_amdgcn_readfirstlane((int)threadIdx.x >> 6);
    if (wid_s == 0) ((LAS unsigned*)(lds + 131072))[pg8::lane_id()] = 0u;
    __syncthreads();
    (void)xcd_barrier_post((unsigned*)args.ws, (volatile LAS unsigned*)(lds + 131072) + 8, (wid_s == 0) && (pg8::lane_id() == 0));
#ifndef PROBE_DUP_PRO
#define PROBE_DUP_PRO 0
#endif
#pragma unroll 1
    for (int prep = 0; prep < 1 + PROBE_DUP_PRO; ++prep) {
        int lane_ = pg8::lane_id(); asm volatile("" : "+v"(lane_)); const int lane = lane_, wave = wid_s, tid = wave * 64 + lane;
        int bx_ = blockIdx.x; asm volatile("" : "+s"(bx_)); const int bx = bx_, G = gridDim.x;
        const int vcu = (G % 8 == 0) ? (bx % 8) * (G / 8) + bx / 8 : bx; const int gw = vcu * NWAVES + wave, NGW = G * NWAVES;
        (void)tid; (void)lane; (void)wave; (void)bx; (void)vcu; (void)gw; (void)NGW;
        int zs = 0; asm volatile("" : "+s"(zs));
        unsigned char* ws = args.ws + zs;
#define INP(k) (args.in[(k) + zs])
        float* out = args.out + zs;
        float* ssq = (float*)(ws + WS_SSQ16); float* logf_buf = (float*)(ws + WS_LOGF);
        bf16* HB = (bf16*)(ws + WS_HB); bf16* HB2 = (bf16*)(ws + WS_HB2); bf16* QO = (bf16*)(ws + WS_QO); bf16* KB = (bf16*)(ws + WS_K); bf16* VB = (bf16*)(ws + WS_V);
        bf16* ACT = (bf16*)(ws + WS_QO); bf16* UP = (bf16*)(ws + WS_UP); bf16* PB = (bf16*)(ws + WS_PB);
        (void)out; (void)ssq; (void)logf_buf; (void)HB; (void)HB2; (void)QO; (void)KB; (void)VB; (void)ACT; (void)UP; (void)PB;
        const float* x = INP(0); const float* p = INP(1); const float* attn_g = INP(2); const float* fox_w_in = INP(3); const float* fox_w_o = INP(5);
        const float* moba_w_in = INP(6); const float* moba_w_o = INP(7); const float* ffn_w_in = INP(10); const float* ffn_w_out = INP(11); const float* ple_w_gate = INP(13); const float* ple_w_up = INP(14); const float* ffn_g = INP(9); const float* ple_g = INP(12);
        LAS float* scr = (LAS float*)(lds + wave * 16384);
        constexpr int IQ = 16 * 96, IO = 16 * 32, IFI = 16 * 176, IFO = 44 * 32, IG = 16 * 32, IU = 4 * 32, IL = IQ + IO + IFI + IFO + IG + IU;
#define DECODE_ITEM(itv, T) do { const int li_ = (itv) / IL; int r = (itv) % IL; const int j = li_ >> 1; const bool fox = !(li_ & 1); bf16* Wl = (bf16*)(ws + WS_W + (size_t)li_ * W_LAYER); \
            if (r < IQ) { const int kb = r / 96, nb = r % 96; T = TItem{fox ? fox_w_in + (size_t)j * 1024 * 3088 : moba_w_in + (size_t)j * 1024 * 3072, attn_g + li_ * 1024, Wl + WO_QKV, fox ? 3088 : 3072, 1024, 64 * kb, 32 * nb, 32 * nb}; break; } r -= IQ; \
            if (r < IO) { const int kb = r / 32, nb = r % 32; T = TItem{(fox ? fox_w_o : moba_w_o) + (size_t)j * 1024 * 1024, nullptr, Wl + WO_O, 1024, 1024, 64 * kb, 32 * nb, 32 * nb}; break; } r -= IO; \
            if (r < IFI) { const int kb = r / 176, nb = r % 176; const int c0 = 32 * nb, bj = c0 / 2816, jj = c0 % 2816; T = TItem{ffn_w_in + (size_t)li_ * 1024 * 5632, ffn_g + li_ * 1024, Wl + WO_FI, 5632, 1024, 64 * kb, c0, 256 * (jj / 128) + 128 * bj + (jj % 128)}; break; } r -= IFI; \
            if (r < IFO) { const int kb = r / 32, nb = r % 32; T = TItem{ffn_w_out + (size_t)li_ * 2816 * 1024, nullptr, Wl + WO_FO, 1024, 2816, 64 * kb, 32 * nb, 32 * nb}; break; } r -= IFO; \
            if (r < IG) { const int kb = r / 32, nb = r % 32; T = TItem{ple_w_gate + (size_t)li_ * 1024 * 1024, ple_g + li_ * 1024, Wl + WO_G, 1024, 1024, 64 * kb, 32 * nb, 32 * nb}; break; } r -= IG; \
            { const int kb = r / 32, nb = r % 32; T = TItem{ple_w_up + (size_t)li_ * 256 * 1024, nullptr, Wl + WO_U, 1024, 256, 64 * kb, 32 * nb, 32 * nb}; } } while (0)
        for (int it = gw; it < DEPTH * IL; it += 2 * NGW) {
            const bool hasB = it + NGW < DEPTH * IL;
            TItem TA, TB; DECODE_ITEM(it, TA); DECODE_ITEM(hasB ? it + NGW : it, TB);
            f32x4 va[8], vb[8]; titem_load(TA, va, lane); titem_load(TB, vb, lane);
            titem_store(TA, va, scr, lane); if (hasB) titem_store(TB, vb, scr, lane);
        }
#undef DECODE_ITEM
        const int gt = vcu * (NWAVES * 64) + tid, NGT = G * NWAVES * 64;
        for (int idx = gt; idx < 2 * 16384; idx += NGT) { const int j = idx >> 14, hh = (idx >> 10) & 15, k = idx & 1023;
            bf16* Wl = (bf16*)(ws + WS_W + (size_t)(2 * j) * W_LAYER);
            Wl[WO_F + hh * 1024 + k] = (bf16)(pg8::pk_f16(fox_w_in[(size_t)j * 1024 * 3088 + (size_t)k * 3088 + 3072 + hh] * attn_g[2 * j * 1024 + k], 0.f) & 0xffffu); }
        { constexpr size_t NP8 = (size_t)DEPTH * M * PD / 8;
          for (size_t idx = gt; idx < NP8; idx += (size_t)4 * NGT) { f32x4 a[4], b[4];
#pragma unroll
              for (int q = 0; q < 4; ++q) { const size_t i2 = idx + (size_t)q * NGT; if (i2 < NP8) { a[q] = *(const f32x4*)(p + i2 * 8); b[q] = *(const f32x4*)(p + i2 * 8 + 4); } }
#pragma unroll
              for (int q = 0; q < 4; ++q) { const size_t i2 = idx + (size_t)q * NGT; if (i2 < NP8) { v4u o; o.x = pk2(a[q][0], a[q][1]); o.y = pk2(a[q][2], a[q][3]); o.z = pk2(b[q][0], b[q][1]); o.w = pk2(b[q][2], b[q][3]); *(v4u*)(PB + i2 * 8) = o; } } } }
        for (int row = gw; row < M; row += 2 * NGW) {
            const int row2 = row + NGW < M ? row + NGW : row;
            const f32x4* xr = (const f32x4*)(x + (size_t)row * D) + lane; const f32x4* xr2 = (const f32x4*)(x + (size_t)row2 * D) + lane;
            f32x4 v[4], w[4];
#pragma unroll
            for (int jx = 0; jx < 4; ++jx) { v[jx] = xr[64 * jx]; w[jx] = xr2[64 * jx]; }
            float s = 0.f, s2 = 0.f; unsigned long long* o8 = (unsigned long long*)(HB2 + (size_t)row * D) + lane; unsigned long long* o82 = (unsigned long long*)(HB2 + (size_t)row2 * D) + lane;
#pragma unroll
            for (int jx = 0; jx < 4; ++jx) { s += (v[jx][0] * v[jx][0] + v[jx][1] * v[jx][1]) + (v[jx][2] * v[jx][2] + v[jx][3] * v[jx][3]); s2 += (w[jx][0] * w[jx][0] + w[jx][1] * w[jx][1]) + (w[jx][2] * w[jx][2] + w[jx][3] * w[jx][3]);
                o8[64 * jx] = (unsigned long long)pg8::pk_f16(v[jx][0], v[jx][1]) | ((unsigned long long)pg8::pk_f16(v[jx][2], v[jx][3]) << 32);
                o82[64 * jx] = (unsigned long long)pg8::pk_f16(w[jx][0], w[jx][1]) | ((unsigned long long)pg8::pk_f16(w[jx][2], w[jx][3]) << 32); }
            s = wave_sum(s); s2 = wave_sum(s2);
            if (lane < 16) { ssq[(size_t)row * 16 + lane] = (lane == 0) ? s : 0.f; ssq[(size_t)row2 * 16 + lane] = (lane == 0) ? s2 : 0.f; } }
        (void)attn_g;
    }
    if (args.ws == nullptr) grid.sync();
    GRID_SYNC();

    layer_fwd<0>(args, lds, wid_s); layer_fwd<1>(args, lds, wid_s); layer_fwd<2>(args, lds, wid_s); layer_fwd<3>(args, lds, wid_s);
    {
        int lane_ = pg8::lane_id(); asm volatile("" : "+v"(lane_)); const int lane = lane_, wave = wid_s, tid = wave * 64 + lane;
        int bx_ = blockIdx.x; asm volatile("" : "+s"(bx_)); const int bx = bx_, G = gridDim.x;
        const int vcu = (G % 8 == 0) ? (bx % 8) * (G / 8) + bx / 8 : bx; const int gw = vcu * NWAVES + wave, NGW = G * NWAVES;
        (void)tid; (void)lane; (void)wave; (void)bx; (void)vcu; (void)gw; (void)NGW;
      float* out = args.out; const float* fin_g = args.in[15]; const float* ssq_f = (const float*)(args.ws + WS_SSQ16);
      const bf16* HF = (const bf16*)(args.ws + WS_HB2);
      const f32x4* gr = (const f32x4*)fin_g + lane; f32x4 gv[4];
#pragma unroll
      for (int jx = 0; jx < 4; ++jx) gv[jx] = gr[64 * jx];
      for (int row = gw; row < M; row += 2 * NGW) {
          const int row2 = row + NGW < M ? row + NGW : row;
          const unsigned long long* hr = (const unsigned long long*)(HF + (size_t)row * D) + lane; const unsigned long long* hr2 = (const unsigned long long*)(HF + (size_t)row2 * D) + lane;
          unsigned long long v[4], w[4];
#pragma unroll
          for (int jx = 0; jx < 4; ++jx) { v[jx] = hr[64 * jx]; w[jx] = hr2[64 * jx]; }
          const float rs = pg8::rstd_row(ssq_f, row), rs2 = pg8::rstd_row(ssq_f, row2);
          f32x4* xr = (f32x4*)(out + (size_t)row * D) + lane; f32x4* xr2 = (f32x4*)(out + (size_t)row2 * D) + lane;
#pragma unroll
          for (int jx = 0; jx < 4; ++jx) {
              const f32x4 a = {pg8::f16_lo((unsigned)v[jx]), pg8::f16_hi((unsigned)v[jx]), pg8::f16_lo((unsigned)(v[jx] >> 32)), pg8::f16_hi((unsigned)(v[jx] >> 32))};
              const f32x4 b = {pg8::f16_lo((unsigned)w[jx]), pg8::f16_hi((unsigned)w[jx]), pg8::f16_lo((unsigned)(w[jx] >> 32)), pg8::f16_hi((unsigned)(w[jx] >> 32))};
              xr[64 * jx] = a * rs * gv[jx]; if (row2 != row) xr2[64 * jx] = b * rs2 * gv[jx]; } } }
}

extern "C" void kernel_launch(void* const* d_in, const int* in_sizes, int n_in, void* d_out, int out_size, void* d_ws, size_t ws_size, hipStream_t stream) {
    static int grid = 0;
    if (grid == 0) {
        if (n_in != 16 || in_sizes[0] != M * D || out_size != M * D || ws_size < WS_END) { fprintf(stderr, "kernel_launch: unexpected shapes / workspace (n_in %d, ws %zu)\n", n_in, ws_size); grid = -1; return; }
        int dev = 0, cus = 0, per_cu = 0;
        hipGetDevice(&dev); hipDeviceGetAttribute(&cus, hipDeviceAttributeMultiprocessorCount, dev);
        if (hipFuncSetAttribute((const void*)fwd_megakernel, hipFuncAttributeMaxDynamicSharedMemorySize, LDS_BYTES) != hipSuccess) { fprintf(stderr, "kernel_launch: hipFuncSetAttribute failed\n"); grid = -1; return; }
        hipOccupancyMaxActiveBlocksPerMultiprocessor(&per_cu, (const void*)fwd_megakernel, NWAVES * 64, LDS_BYTES);
        (void)hipGetLastError();
        if (per_cu < 1) per_cu = 1;
        grid = cus;
        if (grid % 8 != 0 || grid > 256) grid = grid > 256 ? 256 : grid;
    }
    if (grid < 0) return;
    if (hipMemsetAsync(d_ws, 0, 131072, stream) != hipSuccess) { fprintf(stderr, "kernel_launch: hipMemsetAsync of the control words failed\n"); return; }
    Args a{};
    for (int i = 0; i < 16; ++i) a.in[i] = (const float*)d_in[i];
    a.out = (float*)d_out; a.ws = (unsigned char*)d_ws;
    void* kargs[] = {&a};
    hipError_t e = hipLaunchCooperativeKernel((const void*)fwd_megakernel, dim3(grid), dim3(NWAVES * 64), kargs, LDS_BYTES, stream);
    if (e != hipSuccess) fprintf(stderr, "kernel_launch: cooperative launch failed: %s (grid %d)\n", hipGetErrorString(e), grid);
}
```
